# Optimizing an MI355X kernel written in HIP

```python
import math
import jax, jax.numpy as jnp
from jax import lax
import numpy as np

D_MODEL = 2048
BATCH = 2
SEQ = 8192
DEPTH = 1

HEAD_DIM = 128
BLOCK = 128
EPS = 1e-6
DIL_PATTERNS = ((128, 1), (512, 4), (2048, 16))
N_GROUPS = len(DIL_PATTERNS)
A_HEADS_PER_GROUP = 8
A_HEADS = N_GROUPS * A_HEADS_PER_GROUP
A_WIDTH = A_HEADS * HEAD_DIM
A_OUT = A_HEADS_PER_GROUP * HEAD_DIM
B_Q_HEADS = 16
B_KV_HEADS = 2
B_GROUP = B_Q_HEADS // B_KV_HEADS
B_WINDOW = 128
B_Q_WIDTH = B_Q_HEADS * HEAD_DIM
B_KV_WIDTH = B_KV_HEADS * HEAD_DIM
D_FF = 4 * D_MODEL
N_ATTN_HEADS = B_Q_HEADS + A_HEADS
OFF_QA = 0
OFF_KA = OFF_QA + A_WIDTH
OFF_VA = OFF_KA + A_WIDTH
OFF_QB = OFF_VA + A_WIDTH
OFF_KB = OFF_QB + B_Q_WIDTH
OFF_VB = OFF_KB + B_KV_WIDTH
OFF_GA = OFF_VB + B_KV_WIDTH
OFF_GB = OFF_GA + D_MODEL
IN_COLS = OFF_GB + D_MODEL

kernel_name = "hybrid_dilated_swa_sink_gated_block"


def alibi_slopes():
    i = np.arange(1, N_ATTN_HEADS + 1, dtype=np.float32)
    return (2.0 ** (-8.0 * i / N_ATTN_HEADS)).astype(np.float32)


def rmsnorm(x, g):
    xf = x.astype(jnp.float32)
    y = xf * lax.rsqrt(jnp.mean(xf * xf, axis=-1, keepdims=True) + EPS)
    return (y * g.astype(jnp.float32)).astype(x.dtype)


def banded_attention(q, k, v, slopes, stride, max_back, sink=None):
    N, L0, Hk, G, D = q.shape
    pad = (-L0) % BLOCK
    if pad:
        q = jnp.pad(q, ((0, 0), (0, pad), (0, 0), (0, 0), (0, 0)))
        k = jnp.pad(k, ((0, 0), (0, pad), (0, 0), (0, 0)))
        v = jnp.pad(v, ((0, 0), (0, pad), (0, 0), (0, 0)))
    L = L0 + pad
    nb = L // BLOCK
    qb = q.reshape(N, nb, BLOCK, Hk, G, D)

    def band(a):
        cur = a.reshape(N, nb, BLOCK, Hk, D)
        prev = jnp.pad(cur, ((0, 0), (1, 0), (0, 0), (0, 0), (0, 0)))[:, :-1]
        return jnp.concatenate([prev, cur], axis=2)

    kb, vb = band(k), band(v)
    s = jnp.einsum('nbqhgd,nbkhd->nbhgqk', qb, kb).astype(jnp.float32) * (HEAD_DIM ** -0.5)
    qi = np.arange(BLOCK) + BLOCK
    ki = np.arange(2 * BLOCK)
    rel = qi[:, None] - ki[None, :]
    kpos = np.arange(nb)[:, None, None] * BLOCK - BLOCK + ki[None, None, :]
    valid = ((rel >= 0) & (rel <= max_back))[None] & (kpos >= 0)
    bias = -slopes.astype(jnp.float32)[:, :, None, None] * jnp.asarray(stride * rel, jnp.float32)
    s = jnp.where(jnp.asarray(valid)[None, :, None, None], s + bias[None, None], -jnp.inf)
    m = jnp.max(s, axis=-1)
    if sink is not None:
        sink_f = sink.astype(jnp.float32)[None, None, :, :, None]
        m = jnp.maximum(m, sink_f)
    p = jnp.exp(s - m[..., None])
    denom = jnp.sum(p, axis=-1)
    if sink is not None:
        denom = denom + jnp.exp(sink_f - m)
    o = jnp.einsum('nbhgqk,nbkhd->nbqhgd', p.astype(v.dtype), vb).astype(jnp.float32)
    denom_q = jnp.moveaxis(denom, -1, 2)
    o = o / denom_q[..., None]
    lse = jnp.moveaxis(m, -1, 2) + jnp.log(denom_q)
    o = o.reshape(N, L, Hk, G, D)[:, :L0]
    lse = lse.reshape(N, L, Hk, G)[:, :L0]
    return o, lse


def dilated_group(q, k, v, slopes, window, dilation):
    Bn, T, H, D = q.shape
    Ls = T // dilation

    def gather(a):
        return a.reshape(Bn, Ls, dilation, H, D).transpose(0, 2, 1, 3, 4).reshape(Bn * dilation, Ls, H, D)

    o, lse = banded_attention(gather(q)[:, :, :, None, :], gather(k), gather(v),
                              slopes[:, None], dilation, window // dilation)
    o = o.reshape(Bn, dilation, Ls, H, D).transpose(0, 2, 1, 3, 4).reshape(Bn, T, H, D)
    lse = lse.reshape(Bn, dilation, Ls, H).transpose(0, 2, 1, 3).reshape(Bn, T, H)
    return o, lse


def setup_inputs(seed: int = 0) -> dict:
    key = jax.random.key(seed)
    ks = jax.random.split(key, 15)
    f32 = jnp.float32

    def w(k, shape, fan_in):
        return jax.random.normal(k, shape, f32) * (fan_in ** -0.5)

    def gain(k, shape):
        return 1.0 + 0.1 * jax.random.normal(k, shape, f32)

    return {
        "x": jax.random.normal(ks[0], (BATCH, SEQ, D_MODEL), f32),
        "norm1_g": gain(ks[1], (DEPTH, D_MODEL)),
        "w_in": w(ks[2], (DEPTH, D_MODEL, IN_COLS), D_MODEL),
        "q_norm_a": gain(ks[3], (DEPTH, HEAD_DIM)),
        "k_norm_a": gain(ks[4], (DEPTH, HEAD_DIM)),
        "q_norm_b": gain(ks[5], (DEPTH, HEAD_DIM)),
        "k_norm_b": gain(ks[6], (DEPTH, HEAD_DIM)),
        "sinks_b": 0.5 * jax.random.normal(ks[7], (DEPTH, B_Q_HEADS), f32),
        "w_branch_a": w(ks[8], (DEPTH, A_OUT, D_MODEL), A_OUT),
        "w_branch_b": w(ks[9], (DEPTH, B_Q_WIDTH, D_MODEL), B_Q_WIDTH),
        "w_out": w(ks[10], (DEPTH, D_MODEL, D_MODEL), D_MODEL),
        "norm2_g": gain(ks[11], (DEPTH, D_MODEL)),
        "w_ff1": w(ks[12], (DEPTH, D_MODEL, D_FF), D_MODEL),
        "w_ff2": w(ks[13], (DEPTH, D_FF, D_MODEL), D_FF),
    }


def reference(x, norm1_g, w_in, q_norm_a, k_norm_a, q_norm_b, k_norm_b, sinks_b,
              w_branch_a, w_branch_b, w_out, norm2_g, w_ff1, w_ff2):
    Bn, T, _ = x.shape
    slopes = jnp.asarray(alibi_slopes())
    slopes_b = slopes[:B_Q_HEADS].reshape(B_KV_HEADS, B_GROUP)
    slopes_a = slopes[B_Q_HEADS:].reshape(N_GROUPS, A_HEADS_PER_GROUP)
    for l in range(DEPTH):
        h = rmsnorm(x, norm1_g[l])
        proj = h @ w_in[l]
        shp_a = (Bn, T, N_GROUPS, A_HEADS_PER_GROUP, HEAD_DIM)
        qa = rmsnorm(proj[..., OFF_QA:OFF_KA].reshape(shp_a), q_norm_a[l])
        ka = rmsnorm(proj[..., OFF_KA:OFF_VA].reshape(shp_a), k_norm_a[l])
        va = proj[..., OFF_VA:OFF_QB].reshape(shp_a)
        outs, lses = [], []
        for g, (window, dilation) in enumerate(DIL_PATTERNS):
            o_g, lse_g = dilated_group(qa[:, :, g], ka[:, :, g], va[:, :, g], slopes_a[g], window, dilation)
            outs.append(o_g)
            lses.append(lse_g)
        alpha = jax.nn.softmax(jnp.stack(lses, axis=0), axis=0)
        o_a = jnp.sum(alpha[..., None] * jnp.stack(outs, axis=0), axis=0)
        o_a = o_a.reshape(Bn, T, A_OUT).astype(x.dtype)

        qb = rmsnorm(proj[..., OFF_QB:OFF_KB].reshape(Bn, T, B_KV_HEADS, B_GROUP, HEAD_DIM), q_norm_b[l])
        kb = rmsnorm(proj[..., OFF_KB:OFF_VB].reshape(Bn, T, B_KV_HEADS, HEAD_DIM), k_norm_b[l])
        vb = proj[..., OFF_VB:OFF_GA].reshape(Bn, T, B_KV_HEADS, HEAD_DIM)
        o_b, _ = banded_attention(qb, kb, vb, slopes_b, 1, B_WINDOW - 1,
                                  sinks_b[l].reshape(B_KV_HEADS, B_GROUP))
        o_b = o_b.reshape(Bn, T, B_Q_WIDTH).astype(x.dtype)

        gate_a = jax.nn.sigmoid(proj[..., OFF_GA:OFF_GB])
        gate_b = jax.nn.sigmoid(proj[..., OFF_GB:IN_COLS])
        merged = gate_a * (o_a @ w_branch_a[l]) + gate_b * (o_b @ w_branch_b[l])
        x = x + merged @ w_out[l]
        h2 = rmsnorm(x, norm2_g[l])
        x = x + jnp.square(jax.nn.relu(h2 @ w_ff1[l])) @ w_ff2[l]
    return x
```

```cpp
#include <hip/hip_runtime.h>
#include <hip/hip_cooperative_groups.h>
#include <cstdio>
namespace cg = cooperative_groups;

namespace pg8 {
#define PG8_LAS __attribute__((address_space(3)))
typedef unsigned short bf16_t;
typedef short bf16x8 __attribute__((ext_vector_type(8)));
typedef float f32x4 __attribute__((ext_vector_type(4)));
typedef unsigned u32x4 __attribute__((ext_vector_type(4)));
constexpr int BM = 256, BK = 64, HALF = 128, HTB = HALF * BK * 2  , STAGE_BYTES = 8 * HTB, NXCD = 8, WGM = 8;

__host__ __device__ __forceinline__ int lds_byte(int r, int c) { const int st = (r >> 4) * 2 + (c >> 5), rr = r & 15, cc = c & 31, ob = rr * 64 + cc * 2; return st * 1024 + (ob ^ (((ob >> 9) & 1) << 5)); }
__host__ __device__ __forceinline__ void stage_rc(int b, int& R, int& C) { const int st = b / 1024, sb = b % 1024, swz = sb ^ (((sb >> 9) & 1) << 5); R = (st >> 1) * 16 + swz / 64; C = (st & 1) * 32 + (swz % 64) / 2; }
__host__ __device__ __forceinline__ int perm32(int rho) { const int n = rho >> 4, i = rho & 15; return 8 * (i >> 2) + 4 * n + (i & 3); }

struct Unit { int pm, pn; };
struct Gemm { const bf16_t* A; const bf16_t* Bt; int M, N, K; int lda = 0; };

struct StaticOrder {
    int nM, nN, nwg, G, c, flip;
    __host__ __device__ void init(int M, int N, int G_, int c_, int flip_ = 0) { nM = M / BM; nN = N / BM; nwg = nM * nN; G = G_; c = c_; flip = flip_; }
    __host__ __device__ bool next(int i, Unit& u) const {
        const long L = (long)i * G + c; if (L >= nwg) return false;
        int wgid = (int)L; { const int q = nwg / NXCD, r = nwg % NXCD, xcd = wgid % NXCD, off = wgid / NXCD; wgid = (xcd < r ? xcd * (q + 1) : r * (q + 1) + (xcd - r) * q) + off; }
        const int nig = WGM * nN, gid = wgid / nig, fm = gid * WGM, gsz = (nM - fm) < WGM ? (nM - fm) : WGM;
        u.pm = fm + ((wgid % nig) % gsz); u.pn = (wgid % nig) / gsz; if (flip) u.pn = nN - 1 - u.pn; return true;
    }
    __device__ __forceinline__ void a_ready(const Unit&) const {}
    __device__ __forceinline__ void done(const Unit&) const {}
};
__device__ __forceinline__ unsigned cvt_pk_bf16(float lo, float hi) { unsigned r; asm("v_cvt_pk_bf16_f32 %0, %1, %2" : "=v"(r) : "v"(lo), "v"(hi)); return r; }
typedef float f32x2 __attribute__((ext_vector_type(2)));
typedef unsigned u32x2 __attribute__((ext_vector_type(2)));
__device__ __forceinline__ float bf_lo(unsigned w) { return __uint_as_float(w << 16); }
__device__ __forceinline__ float bf_hi(unsigned w) { return __uint_as_float(w & 0xffff0000u); }

struct EpiProj {
    static constexpr bool PERM = true, AFTER_DRAIN = false;
    bf16_t *QA, *KA, *VA, *QB, *KB, *VB, *GA, *GB;
    __device__ __forceinline__ void operator()(const f32x4 (&acc)[2][2][4][2], const Unit& u, int wr, int wc, int fr, int fq, PG8_LAS unsigned char* xl) const {
        const int pn = u.pn; int mode, ldc, colt; bf16_t* base; int gsel = 0;
        if (pn < 12)       { mode = 1; base = QA; ldc = 3072; colt = pn * 256; gsel = 0; }
        else if (pn < 24)  { mode = 1; base = KA; ldc = 3072; colt = (pn - 12) * 256; gsel = 1; }
        else if (pn < 36)  { mode = 0; base = VA; ldc = 3072; colt = (pn - 24) * 256; }
        else if (pn < 44)  { mode = 1; base = QB; ldc = 2048; colt = (pn - 36) * 256; gsel = 2; }
        else if (pn == 44) { mode = 1; base = KB; ldc = 256; colt = 0; gsel = 3; }
        else if (pn == 45) { mode = 0; base = VB; ldc = 256; colt = 0; }
        else if (pn < 54)  { mode = 2; base = GA; ldc = 2048; colt = (pn - 46) * 256; }
        else               { mode = 2; base = GB; ldc = 2048; colt = (pn - 54) * 256; }
        const int row0 = u.pm * BM + wr * 64 + fr, col0 = colt + wc * 32 + 8 * fq;
        if (mode == 1) {
            PG8_LAS float* T = (PG8_LAS float*)xl;
#pragma unroll
            for (int ai = 0; ai < 2; ++ai)
#pragma unroll
                for (int m = 0; m < 4; ++m)
#pragma unroll
                    for (int bj = 0; bj < 2; ++bj) {
                        const f32x4 a = acc[ai][bj][m][0], b = acc[ai][bj][m][1];
                        float s = (a[0] * a[0] + a[1] * a[1]) + (a[2] * a[2] + a[3] * a[3]) + (b[0] * b[0] + b[1] * b[1]) + (b[2] * b[2] + b[3] * b[3]);
                        s += __shfl_xor(s, 16); s += __shfl_xor(s, 32);
                        if (fq == 0) T[((ai * HALF + wr * 64 + m * 16 + fr) * 2 + bj) * 4 + wc] = s;
                    }
            asm volatile("s_waitcnt lgkmcnt(0)" ::: "memory"); __builtin_amdgcn_s_barrier(); asm volatile("" ::: "memory");
            const PG8_LAS float* gl = (const PG8_LAS float*)(xl + 8192) + gsel * 128 + wc * 32 + 8 * fq;
            const f32x4 g0 = *(const PG8_LAS f32x4*)gl, g1 = *(const PG8_LAS f32x4*)(gl + 4);
#pragma unroll
            for (int ai = 0; ai < 2; ++ai)
#pragma unroll
                for (int m = 0; m < 4; ++m) { bf16_t* rowp = base + (size_t)(row0 + ai * HALF + m * 16) * ldc + col0;
#pragma unroll
                    for (int bj = 0; bj < 2; ++bj) {
                        const f32x4 t = *(const PG8_LAS f32x4*)(T + ((ai * HALF + wr * 64 + m * 16 + fr) * 2 + bj) * 4);
                        const float rs = rsqrtf(((t[0] + t[1]) + (t[2] + t[3])) * (1.0f / 128.0f) + 1e-6f);
                        const f32x4 v0 = acc[ai][bj][m][0] * rs * g0, v1 = acc[ai][bj][m][1] * rs * g1;
                        u32x4 w; w.x = cvt_pk_bf16(v0[0], v0[1]); w.y = cvt_pk_bf16(v0[2], v0[3]); w.z = cvt_pk_bf16(v1[0], v1[1]); w.w = cvt_pk_bf16(v1[2], v1[3]);
                        *(u32x4*)(rowp + bj * HALF) = w; } }
        } else {
#pragma unroll
            for (int ai = 0; ai < 2; ++ai)
#pragma unroll
                for (int m = 0; m < 4; ++m) { bf16_t* rowp = base + (size_t)(row0 + ai * HALF + m * 16) * ldc + col0;
#pragma unroll
                    for (int bj = 0; bj < 2; ++bj) { f32x4 v0 = acc[ai][bj][m][0], v1 = acc[ai][bj][m][1];
                        if (mode == 2) {
#pragma unroll
                            for (int j = 0; j < 4; ++j) { v0[j] = __builtin_amdgcn_rcpf(1.0f + __expf(-v0[j])); v1[j] = __builtin_amdgcn_rcpf(1.0f + __expf(-v1[j])); } }
                        u32x4 w; w.x = cvt_pk_bf16(v0[0], v0[1]); w.y = cvt_pk_bf16(v0[2], v0[3]); w.z = cvt_pk_bf16(v1[0], v1[1]); w.w = cvt_pk_bf16(v1[2], v1[3]);
                        if (mode == 2) __builtin_nontemporal_store(w, (u32x4*)(rowp + bj * HALF)); else *(u32x4*)(rowp + bj * HALF) = w; } }
        }
    }
};
struct EpiGate {
    static constexpr bool PERM = true, AFTER_DRAIN = false;
    const bf16_t* G; const bf16_t* addend; bf16_t* out; int ldc;
    __device__ __forceinline__ void operator()(const f32x4 (&acc)[2][2][4][2], const Unit& u, int wr, int wc, int fr, int fq, PG8_LAS unsigned char*) const {
        const int row0 = u.pm * BM + wr * 64 + fr, col0 = u.pn * BM + wc * 32 + 8 * fq;
#pragma unroll
        for (int ai = 0; ai < 2; ++ai)
#pragma unroll
            for (int m = 0; m < 4; ++m) { const size_t roff = (size_t)(row0 + ai * HALF + m * 16) * ldc + col0;
#pragma unroll
                for (int bj = 0; bj < 2; ++bj) { const size_t off = roff + bj * HALF;
                    const u32x4 gw = __builtin_nontemporal_load((const u32x4*)(G + off));     f32x4 v0 = acc[ai][bj][m][0], v1 = acc[ai][bj][m][1];
                    v0[0] *= bf_lo(gw.x); v0[1] *= bf_hi(gw.x); v0[2] *= bf_lo(gw.y); v0[3] *= bf_hi(gw.y);
                    v1[0] *= bf_lo(gw.z); v1[1] *= bf_hi(gw.z); v1[2] *= bf_lo(gw.w); v1[3] *= bf_hi(gw.w);
                    if (addend) { const u32x4 aw = *(const u32x4*)(addend + off);
                        v0[0] += bf_lo(aw.x); v0[1] += bf_hi(aw.x); v0[2] += bf_lo(aw.y); v0[3] += bf_hi(aw.y);
                        v1[0] += bf_lo(aw.z); v1[1] += bf_hi(aw.z); v1[2] += bf_lo(aw.w); v1[3] += bf_hi(aw.w); }
                    u32x4 w; w.x = cvt_pk_bf16(v0[0], v0[1]); w.y = cvt_pk_bf16(v0[2], v0[3]); w.z = cvt_pk_bf16(v1[0], v1[1]); w.w = cvt_pk_bf16(v1[2], v1[3]);
                    *(u32x4*)(out + off) = w; } }
    }
};
struct EpiResF32 {
    static constexpr bool PERM = true, AFTER_DRAIN = false;
    const float* res; float* out; int ldc;
    __device__ __forceinline__ void operator()(const f32x4 (&acc)[2][2][4][2], const Unit& u, int wr, int wc, int fr, int fq, PG8_LAS unsigned char*) const {
        const int row0 = u.pm * BM + wr * 64 + fr, col0 = u.pn * BM + wc * 32 + 8 * fq;
#pragma unroll
        for (int ai = 0; ai < 2; ++ai)
#pragma unroll
            for (int m = 0; m < 4; ++m) { const size_t roff = (size_t)(row0 + ai * HALF + m * 16) * ldc + col0;
#pragma unroll
                for (int bj = 0; bj < 2; ++bj)
#pragma unroll
                    for (int n = 0; n < 2; ++n) { const size_t off = roff + bj * HALF + n * 4; const f32x4 r = *(const f32x4*)(res + off); *(f32x4*)(out + off) = r + acc[ai][bj][m][n]; } }
    }
};
struct EpiResX1 {
    static constexpr bool PERM = true, AFTER_DRAIN = false;
    const float* res; bf16_t* xb; float* ssqp; int ldc;
    __device__ __forceinline__ void operator()(const f32x4 (&acc)[2][2][4][2], const Unit& u, int wr, int wc, int fr, int fq, PG8_LAS unsigned char* xl) const {
        const int row0 = u.pm * BM + wr * 64 + fr, col0 = u.pn * BM + wc * 32 + 8 * fq;
        PG8_LAS float* T = (PG8_LAS float*)xl;
#pragma unroll
        for (int ai = 0; ai < 2; ++ai)
#pragma unroll
            for (int m = 0; m < 4; ++m) { const size_t roff = (size_t)(row0 + ai * HALF + m * 16) * ldc + col0; float s = 0.f;
#pragma unroll
                for (int bj = 0; bj < 2; ++bj) { const size_t off = roff + bj * HALF;
                    const f32x4 v0 = __builtin_nontemporal_load((const f32x4*)(res + off)) + acc[ai][bj][m][0], v1 = __builtin_nontemporal_load((const f32x4*)(res + off + 4)) + acc[ai][bj][m][1];
                    u32x4 w; w.x = cvt_pk_bf16(v0[0], v0[1]); w.y = cvt_pk_bf16(v0[2], v0[3]); w.z = cvt_pk_bf16(v1[0], v1[1]); w.w = cvt_pk_bf16(v1[2], v1[3]);
                    *(u32x4*)(xb + off) = w;
                    s += (v0[0] * v0[0] + v0[1] * v0[1]) + (v0[2] * v0[2] + v0[3] * v0[3]) + (v1[0] * v1[0] + v1[1] * v1[1]) + (v1[2] * v1[2] + v1[3] * v1[3]); }
                s += __shfl_xor(s, 16); s += __shfl_xor(s, 32);
                if (fq == 0) T[(ai * HALF + wr * 64 + m * 16 + fr) * 4 + wc] = s; }
        asm volatile("s_waitcnt lgkmcnt(0)" ::: "memory"); __builtin_amdgcn_s_barrier(); asm volatile("" ::: "memory");
        if (wc == 0 && fq == 0) {
#pragma unroll
            for (int ai = 0; ai < 2; ++ai)
#pragma unroll
                for (int m = 0; m < 4; ++m) { const int r = ai * HALF + wr * 64 + m * 16 + fr; const f32x4 t = *(const PG8_LAS f32x4*)(T + r * 4);
                    ssqp[(size_t)(u.pm * BM + r) * 8 + u.pn] = (t[0] + t[1]) + (t[2] + t[3]); } }
    }
};
struct EpiFinal {
    static constexpr bool PERM = true, AFTER_DRAIN = false;
    const bf16_t* res; float* out; int ldc;
    __device__ __forceinline__ void operator()(const f32x4 (&acc)[2][2][4][2], const Unit& u, int wr, int wc, int fr, int fq, PG8_LAS unsigned char*) const {
        const int row0 = u.pm * BM + wr * 64 + fr, col0 = u.pn * BM + wc * 32 + 8 * fq;
#pragma unroll
        for (int ai = 0; ai < 2; ++ai)
#pragma unroll
            for (int m = 0; m < 4; ++m) { const size_t roff = (size_t)(row0 + ai * HALF + m * 16) * ldc + col0;
#pragma unroll
                for (int bj = 0; bj < 2; ++bj) { const size_t off = roff + bj * HALF; const u32x4 rw = __builtin_nontemporal_load((const u32x4*)(res + off));
                    f32x4 v0 = acc[ai][bj][m][0], v1 = acc[ai][bj][m][1];
                    v0[0] += bf_lo(rw.x); v0[1] += bf_hi(rw.x); v0[2] += bf_lo(rw.y); v0[3] += bf_hi(rw.y);
                    v1[0] += bf_lo(rw.z); v1[1] += bf_hi(rw.z); v1[2] += bf_lo(rw.w); v1[3] += bf_hi(rw.w);
                    __builtin_nontemporal_store(v0, (f32x4*)(out + off)); __builtin_nontemporal_store(v1, (f32x4*)(out + off + 4)); } }
    }
};
struct EpiRelu2 {
    static constexpr bool PERM = true, AFTER_DRAIN = false;
    bf16_t* out; int ldc;
    __device__ __forceinline__ void operator()(const f32x4 (&acc)[2][2][4][2], const Unit& u, int wr, int wc, int fr, int fq, PG8_LAS unsigned char* xl) const {
        const int row0 = u.pm * BM + wr * 64 + fr, col0 = u.pn * BM + wc * 32 + 8 * fq;
        const PG8_LAS float* RS = (const PG8_LAS float*)(xl + 8192 + 2048);
#pragma unroll
        for (int ai = 0; ai < 2; ++ai)
#pragma unroll
            for (int m = 0; m < 4; ++m) { const int rl = wr * 64 + fr + ai * HALF + m * 16; bf16_t* rowp = out + (size_t)(u.pm * BM + rl) * ldc + col0;
                const float rs = RS[rl];
#pragma unroll
                for (int bj = 0; bj < 2; ++bj) { f32x4 v0 = acc[ai][bj][m][0], v1 = acc[ai][bj][m][1];
#pragma unroll
                    for (int j = 0; j < 4; ++j) { const float a = fmaxf(v0[j] * rs, 0.f), b = fmaxf(v1[j] * rs, 0.f); v0[j] = a * a; v1[j] = b * b; }
                    u32x4 w; w.x = cvt_pk_bf16(v0[0], v0[1]); w.y = cvt_pk_bf16(v0[2], v0[3]); w.z = cvt_pk_bf16(v1[0], v1[1]); w.w = cvt_pk_bf16(v1[2], v1[3]);
                    *(u32x4*)(rowp + bj * HALF) = w; } }
    }
};

template <class Epi, class Sched>
__device__ __forceinline__ void gemm_phase(PG8_LAS unsigned char* lds, const Gemm g, const Sched& S, const Epi& E) {
    int tid = threadIdx.x; asm volatile("" : "+v"(tid));
    const int wid = __builtin_amdgcn_readfirstlane(tid >> 6), lane = tid & 63, wr = wid >> 2, wc = wid & 3, fr = lane & 15, fq = lane >> 4;
    const int K = g.K, nt = K / BK;
    const int lda = g.lda ? g.lda : K;
    unsigned voffA[2], voffB[2];
#pragma unroll
    for (int i = 0; i < 2; ++i) { int R, C; stage_rc(tid * 16 + i * 8192, R, C); const int Rb = Epi::PERM ? ((R & ~31) + perm32(R & 31)) : R;
        voffA[i] = (unsigned)(R * lda + C) * 2u; voffB[i] = (unsigned)(Rb * K + C) * 2u; }
    const size_t kstep = (size_t)(BK * 2);
    const size_t hstepA = (size_t)HALF * lda * 2, hstepB = (size_t)HALF * K * 2;
    const size_t tstepA = 2 * hstepA, tstepB = 2 * hstepB;
    const unsigned ldsw = (unsigned)wid * 1024u;
    const int aoff = lds_byte(wr * 64 + fr, fq * 8), boff = lds_byte(wc * 32 + fr, fq * 8);
#define PG8_SA(b, h) (((b) * 2 + (h)) * HTB)
#define PG8_SB(b, h) ((4 + (b) * 2 + (h)) * HTB)
#define PG8_STAGE(bufoff, gbase, voff) do { _Pragma("unroll") for (int _i = 0; _i < 2; ++_i) \
        __builtin_amdgcn_global_load_lds((const unsigned*)((const char*)(gbase) + (voff)[_i]), (PG8_LAS unsigned*)(lds + (bufoff) + ldsw + _i * 8192), 16, 0, 0); } while (0)
#define PG8_LDA(dst, b, h) do { _Pragma("unroll") for (int m = 0; m < 4; ++m) _Pragma("unroll") for (int k = 0; k < 2; ++k) dst[m][k] = *(const PG8_LAS bf16x8*)(lds + PG8_SA(b, h) + aoff + m * 2048 + k * 1024); } while (0)
#define PG8_LDB(dst, b, h) do { _Pragma("unroll") for (int n = 0; n < 2; ++n) _Pragma("unroll") for (int k = 0; k < 2; ++k) dst[n][k] = *(const PG8_LAS bf16x8*)(lds + PG8_SB(b, h) + boff + n * 2048 + k * 1024); } while (0)
#define PG8_MMA(ai, bj, At, Bt) do { __builtin_amdgcn_s_setprio(1); _Pragma("unroll") for (int m = 0; m < 4; ++m) _Pragma("unroll") for (int n = 0; n < 2; ++n) _Pragma("unroll") for (int k = 0; k < 2; ++k) \
        acc[ai][bj][m][n] = __builtin_amdgcn_mfma_f32_16x16x32_bf16(Bt[n][k], At[m][k], acc[ai][bj][m][n], 0, 0, 0); __builtin_amdgcn_s_setprio(0); } while (0)
#define PG8_WAIT_V(n) asm volatile("s_waitcnt vmcnt(" #n ")" ::: "memory")
#define PG8_WAIT_L(n) asm volatile("s_waitcnt lgkmcnt(" #n ")" ::: "memory")
#define PG8_BAR __builtin_amdgcn_s_barrier()
#define PG8_SCHED __builtin_amdgcn_sched_barrier(0)
    Unit cur, nxt; int ui = 0;
    if (!S.next(0, cur)) return;
    f32x4 acc[2][2][4][2];
#pragma unroll
    for (int a = 0; a < 2; ++a)
#pragma unroll
        for (int b = 0; b < 2; ++b)
#pragma unroll
            for (int m = 0; m < 4; ++m)
#pragma unroll
                for (int n = 0; n < 2; ++n) acc[a][b][m][n] = (f32x4){0.f, 0.f, 0.f, 0.f};
    bf16x8 At[4][2], B0[2][2], B1[2][2];
    const char* cA = (const char*)g.A + (size_t)cur.pm * tstepA; const char* cB = (const char*)g.Bt + (size_t)cur.pn * tstepB;
    S.a_ready(cur);
    PG8_STAGE(PG8_SB(0, 0), cB, voffB); PG8_STAGE(PG8_SA(0, 0), cA, voffA); PG8_STAGE(PG8_SB(0, 1), cB + hstepB, voffB); PG8_STAGE(PG8_SA(0, 1), cA + hstepA, voffA);
    if (wr == 1) PG8_BAR;
    PG8_WAIT_V(4); PG8_BAR;
    PG8_STAGE(PG8_SB(1, 0), cB + kstep, voffB); PG8_STAGE(PG8_SA(1, 0), cA + kstep, voffA); PG8_STAGE(PG8_SB(1, 1), cB + hstepB + kstep, voffB);
    PG8_WAIT_V(6); PG8_BAR;
    for (;;) {
        const bool has_next = S.next(ui + 1, nxt);
        const char* nA = has_next ? (const char*)g.A + (size_t)nxt.pm * tstepA : cA; const char* nB = has_next ? (const char*)g.Bt + (size_t)nxt.pn * tstepB : cB;
        for (int t = 0; t < nt; t += 2) {
            const bool last = (t == nt - 2);
            const char* a1 = cA + (size_t)(t + 1) * kstep;
            const char* a2 = last ? nA : cA + (size_t)(t + 2) * kstep; const char* b2 = last ? nB : cB + (size_t)(t + 2) * kstep;
            const char* a3 = a2 + kstep; const char* b3 = b2 + kstep;
            if (last && has_next) S.a_ready(nxt);
            PG8_LDB(B0, 0, 0); PG8_SCHED; PG8_LDA(At, 0, 0); PG8_STAGE(PG8_SA(1, 1), a1 + hstepA, voffA);
            PG8_WAIT_L(8); PG8_BAR; PG8_WAIT_L(0); PG8_MMA(0, 0, At, B0); PG8_BAR; PG8_SCHED;
            PG8_LDB(B1, 0, 1); PG8_STAGE(PG8_SB(0, 0), b2, voffB);
            PG8_BAR; PG8_WAIT_L(0); PG8_MMA(0, 1, At, B1); PG8_BAR;
            PG8_LDA(At, 0, 1); PG8_STAGE(PG8_SA(0, 0), a2, voffA);
            PG8_BAR; PG8_WAIT_L(0); PG8_MMA(1, 0, At, B0); PG8_BAR; PG8_SCHED;
            PG8_STAGE(PG8_SB(0, 1), b2 + hstepB, voffB);
            PG8_WAIT_V(6); PG8_BAR; PG8_MMA(1, 1, At, B1); PG8_BAR;
            PG8_LDB(B0, 1, 0); PG8_SCHED; PG8_LDA(At, 1, 0); PG8_STAGE(PG8_SA(0, 1), a2 + hstepA, voffA);
            PG8_WAIT_L(8); PG8_BAR; PG8_WAIT_L(0); PG8_MMA(0, 0, At, B0); PG8_BAR; PG8_SCHED;
            PG8_LDB(B1, 1, 1); PG8_STAGE(PG8_SB(1, 0), b3, voffB);
            PG8_BAR; PG8_WAIT_L(0); PG8_MMA(0, 1, At, B1); PG8_BAR;
            PG8_LDA(At, 1, 1); PG8_STAGE(PG8_SA(1, 0), a3, voffA);
            PG8_BAR; PG8_WAIT_L(0); PG8_MMA(1, 0, At, B0); PG8_BAR; PG8_SCHED;
            PG8_STAGE(PG8_SB(1, 1), b3 + hstepB, voffB);
            PG8_WAIT_V(6); PG8_BAR; PG8_MMA(1, 1, At, B1); PG8_BAR;
        }
        E(acc, cur, wr, wc, fr, fq, lds + STAGE_BYTES); S.done(cur);
        if (!has_next) break;
#pragma unroll
        for (int a = 0; a < 2; ++a)
#pragma unroll
            for (int b = 0; b < 2; ++b)
#pragma unroll
                for (int m = 0; m < 4; ++m)
#pragma unroll
                    for (int n = 0; n < 2; ++n) acc[a][b][m][n] = (f32x4){0.f, 0.f, 0.f, 0.f};
        cur = nxt; cA = nA; cB = nB; ++ui;
    }
    PG8_WAIT_V(0);
    if (wr == 0) PG8_BAR;
    PG8_BAR;
#undef PG8_SA
#undef PG8_SB
#undef PG8_STAGE
#undef PG8_LDA
#undef PG8_LDB
#undef PG8_MMA
#undef PG8_WAIT_V
#undef PG8_WAIT_L
#undef PG8_BAR
#undef PG8_SCHED
}
}

using pg8::bf16_t; using pg8::bf16x8; using pg8::f32x4; using pg8::u32x4; using pg8::u32x2; using pg8::cvt_pk_bf16; using pg8::bf_lo; using pg8::bf_hi;
#define LAS __attribute__((address_space(3)))
typedef short s16x4 __attribute__((ext_vector_type(4)));
constexpr int MT = 16384, TSEQ = 8192, DM = 2048, INC = 15872, DFF = 8192, ACT_LD = DFF + 64;
constexpr size_t MiB = (size_t)1 << 20;
constexpr size_t WS_KA = 0, WS_QA = 96 * MiB, WS_VA = 192 * MiB, WS_QB = 288 * MiB, WS_KB = 352 * MiB, WS_VB = 360 * MiB, WS_GA = 368 * MiB, WS_GB = 432 * MiB,
                 WS_WBA = 496 * MiB, WS_WBB = 500 * MiB, WS_LSE = 508 * MiB, WS_SSQ = 510 * MiB, WS_BAR = 511 * MiB, WS_NEED = 512 * MiB;
constexpr size_t WS_WOUT = 0, WS_WFF1 = 8 * MiB, WS_WFF2 = 40 * MiB;
constexpr size_t WS_MRG = WS_VA, WS_H2 = WS_QA, WS_ACT = 192 * MiB;
constexpr size_t DO_H = 0, DO_WIN = 64 * MiB, DO_OA = 0;
constexpr int LDS_BYTES = 144 * 1024;
constexpr int K_PITCH = 272, V_PITCH = 288, K_LDS = 0, V_LDS = 256 * K_PITCH;

struct Params {
    const float *x, *norm1_g, *w_in, *qna, *kna, *qnb, *knb, *sinks, *wba, *wbb, *wout, *norm2_g, *wff1, *wff2;
    float* out; unsigned char* ws;
};

#define TRRD(dst, base, off) asm volatile("ds_read_b64_tr_b16 %0, %1 offset:%2" : "=&v"(dst) : "v"(base), "i"(off) : "memory")
__device__ __forceinline__ void transpose_convert_impl(const float* __restrict__ W, bf16_t* __restrict__ Wt, int K, int N, const float* __restrict__ kgain, unsigned char* lds_g, const int t_first, const int t_stride) {
    LAS unsigned char* lds = (LAS unsigned char*)lds_g;
    int tid = threadIdx.x; asm volatile("" : "+v"(tid));
    const int lane = tid & 63, w = tid >> 6, c = tid & 63, r = tid >> 6;
    const int tiles_n = N >> 8, nt = tiles_n * (K >> 6);
    const int gg = lane >> 4, i16 = lane & 15, q = i16 >> 2, pp = i16 & 3;
    const int nb = 2 * w + (gg & 1), kb0 = gg >> 1;
    const unsigned rd = (unsigned)(size_t)lds + (unsigned)((8 * kb0 + q) * 576 + (16 * nb + 4 * pp) * 2);
    f32x4 v[8];
    int t = t_first;
    if (t < nt) { const int tk = t / tiles_n, tn = t - tk * tiles_n; const float* src = W + (size_t)((tk << 6) + r) * N + (tn << 8) + 4 * c;
#pragma unroll
        for (int i = 0; i < 8; ++i) v[i] = __builtin_nontemporal_load((const f32x4*)(src + (size_t)(8 * i) * N)); }
    for (; t < nt; t += t_stride) {
        const int tk = t / tiles_n, tn = t - tk * tiles_n, k0 = tk << 6, n0 = tn << 8;
#pragma unroll
        for (int i = 0; i < 8; ++i) { const float g = kgain ? kgain[k0 + r + 8 * i] : 1.0f; u32x2 wv; wv.x = cvt_pk_bf16(v[i][0] * g, v[i][1] * g); wv.y = cvt_pk_bf16(v[i][2] * g, v[i][3] * g);
            *(LAS u32x2*)(lds + (r + 8 * i) * 576 + 8 * c) = wv; }
        const int t2 = t + t_stride;
        if (t2 < nt) { const int tk2 = t2 / tiles_n, tn2 = t2 - tk2 * tiles_n; const float* src = W + (size_t)((tk2 << 6) + r) * N + (tn2 << 8) + 4 * c;
#pragma unroll
            for (int i = 0; i < 8; ++i) v[i] = __builtin_nontemporal_load((const f32x4*)(src + (size_t)(8 * i) * N)); }
        __syncthreads();
        s16x4 lo[4], hi[4];
#pragma unroll
        for (int jj = 0; jj < 4; ++jj) { TRRD(lo[jj], rd, (16 * jj) * 576); TRRD(hi[jj], rd, (16 * jj + 4) * 576); }
        asm volatile("s_waitcnt lgkmcnt(0)" : "+v"(lo[0]), "+v"(lo[1]), "+v"(lo[2]), "+v"(lo[3]), "+v"(hi[0]), "+v"(hi[1]), "+v"(hi[2]), "+v"(hi[3]) :: "memory");
        bf16_t* dst = Wt + (size_t)(n0 + 16 * nb + i16) * K + k0 + 8 * kb0;
#pragma unroll
        for (int jj = 0; jj < 4; ++jj) *(bf16x8*)(dst + 16 * jj) = __builtin_shufflevector(lo[jj], hi[jj], 0, 1, 2, 3, 4, 5, 6, 7);
        __syncthreads();
    }
}
__device__ __forceinline__ void transpose_convert(const float* __restrict__ W, bf16_t* __restrict__ Wt, int K, int N, const float* __restrict__ kgain, unsigned char* lds_g) { transpose_convert_impl(W, Wt, K, N, kgain, lds_g, (int)blockIdx.x, (int)gridDim.x); }
__device__ __forceinline__ void transpose_convert_part(const float* __restrict__ W, bf16_t* __restrict__ Wt, int K, int N, unsigned char* lds_g, int first, int stride) { transpose_convert_impl(W, Wt, K, N, nullptr, lds_g, first, stride); }
__device__ __forceinline__ void rmsnorm_rows(const float* X, const float* __restrict__ g, bf16_t* H) {
    int tid = threadIdx.x; asm volatile("" : "+v"(tid));
    const int lane = tid & 63, wv = blockIdx.x * 8 + (tid >> 6), nw = gridDim.x * 8;
    f32x4 v[8], vn[8];
    if (wv < MT) { const f32x4* xr = (const f32x4*)(X + (size_t)wv * DM);
#pragma unroll
        for (int i = 0; i < 8; ++i) vn[i] = __builtin_nontemporal_load(xr + lane + 64 * i); }
    for (int row = wv; row < MT; row += nw) {
        float s = 0.f;
#pragma unroll
        for (int i = 0; i < 8; ++i) { v[i] = vn[i]; s += (v[i][0] * v[i][0] + v[i][1] * v[i][1]) + (v[i][2] * v[i][2] + v[i][3] * v[i][3]); }
        if (row + nw < MT) { const f32x4* xr = (const f32x4*)(X + (size_t)(row + nw) * DM);
#pragma unroll
            for (int i = 0; i < 8; ++i) vn[i] = __builtin_nontemporal_load(xr + lane + 64 * i); }
#pragma unroll
        for (int o = 32; o >= 1; o >>= 1) s += __shfl_xor(s, o);
        const float rs = rsqrtf(s * (1.0f / DM) + 1e-6f);
#pragma unroll
        for (int i = 0; i < 8; ++i) { const f32x4 gg = ((const f32x4*)g)[lane + 64 * i]; const f32x4 y = v[i] * rs * gg;
            u32x2 w; w.x = cvt_pk_bf16(y[0], y[1]); w.y = cvt_pk_bf16(y[2], y[3]); *(u32x2*)(H + (size_t)row * DM + 4 * (lane + 64 * i)) = w; }
    }
}
#define MFMA16(a, b, c) __builtin_amdgcn_mfma_f32_16x16x32_bf16((a), (b), (c), 0, 0, 0)
struct AUnit { bf16_t* q; const bf16_t* k; const bf16_t* v; float* lse; int ldq, ldk, d, tq0, first, maxback, newkv, reuse, par; float c2, sink2; };
__device__ __forceinline__ void attn_decode(const Params& p, int step, int vb, AUnit& a) {
    const float LOG2E = 1.4426950408889634f;
    const int G = gridDim.x; const bool packed = (G == 256);
    const int u = packed ? (step < 12 ? 12 * vb + step : 3072 + (step - 12) * 256 + vb) : vb + G * step;
    bf16_t* QA = (bf16_t*)(p.ws + WS_QA); const bf16_t* KA = (const bf16_t*)(p.ws + WS_KA); const bf16_t* VA = (const bf16_t*)(p.ws + WS_VA);
    bf16_t* QB = (bf16_t*)(p.ws + WS_QB); const bf16_t* KB = (const bf16_t*)(p.ws + WS_KB); const bf16_t* VB = (const bf16_t*)(p.ws + WS_VB);
    int hidx;
    a.par = step & 1;
    if (u < 3072) { const int b = u / 1536, rem = u - b * 1536, grp = rem >> 9, h = (rem >> 6) & 7, jr = rem & 63;
        a.d = 1 << (2 * grp); const int nb = 64 >> (2 * grp), r = jr / nb, jb = jr - r * nb;
        a.tq0 = jb * 128 * a.d + r; a.first = (jb == 0);
        const size_t hoff = (size_t)b * TSEQ * 3072 + (size_t)(grp * 8 + h) * 128;
        a.q = QA + hoff; a.k = KA + hoff; a.v = VA + hoff; a.ldq = 3072; a.ldk = 3072; hidx = 16 + grp * 8 + h; a.maxback = 128; a.sink2 = -INFINITY;
        a.lse = (float*)(p.ws + WS_LSE) + ((size_t)grp * MT + (size_t)b * TSEQ) * 8 + h; a.newkv = 1;
        a.reuse = (packed && step > 0 && jb != 0);
    } else { const int u2 = u - 3072, qh = u2 >> 8, sup = u2 & 255, j = sup & 63, kvh = (sup >> 6) & 1, b = sup >> 7;
        a.d = 1; a.tq0 = j * 128; a.first = (j == 0);
        a.q = QB + (size_t)b * TSEQ * 2048 + (size_t)(kvh * 8 + qh) * 128; a.ldq = 2048;
        a.k = KB + (size_t)b * TSEQ * 256 + (size_t)kvh * 128; a.v = VB + (size_t)b * TSEQ * 256 + (size_t)kvh * 128; a.ldk = 256;
        hidx = kvh * 8 + qh; a.maxback = 127; a.sink2 = p.sinks[hidx] * LOG2E; a.lse = nullptr; a.newkv = (qh == 0) || !packed; a.reuse = 0;
        if (packed) a.par = 0; }
    a.c2 = exp2f(-0.2f * (float)(hidx + 1)) * (float)a.d * LOG2E;
}
__device__ __forceinline__ void attn_issue(const AUnit& a, int tid, int wid, int q16, int g, u32x4 (&kr)[4], u32x4 (&vr)[4], bf16x8 (&qf)[4]) {
    const int ch = tid & 15, r0 = tid >> 4;
    if (a.newkv) {
#pragma unroll
        for (int i = 0; i < 4; ++i) { const size_t off = (size_t)(a.tq0 + (r0 + 32 * i) * a.d) * a.ldk + 8 * ch;
            kr[i] = *(const u32x4*)(a.k + off); vr[i] = *(const u32x4*)(a.v + off); } }
    const bf16_t* qrow = a.q + (size_t)(a.tq0 + (16 * wid + q16) * a.d) * a.ldq;
#pragma unroll
    for (int ks = 0; ks < 4; ++ks) qf[ks] = *(const bf16x8*)(qrow + 32 * ks + 8 * g);
}
__device__ __forceinline__ void attn_phase(const Params& p, unsigned char* lds_g) {
    LAS unsigned char* lds = (LAS unsigned char*)lds_g;
    int tid = threadIdx.x; asm volatile("" : "+v"(tid));
    const int lane = tid & 63, wid = __builtin_amdgcn_readfirstlane(tid >> 6), q16 = lane & 15, g = lane >> 4;
    const int G = gridDim.x, vb = (G % 8 == 0) ? ((int)(blockIdx.x & 7) * (G >> 3) + (int)(blockIdx.x >> 3)) : (int)blockIdx.x;
    const int nsteps = (G == 256) ? 20 : (5120 - vb + G - 1) / G;
    const float LN2 = 0.6931471805599453f;
    const float c1 = 0.08838834764831845f * 1.4426950408889634f;
    const int ch = tid & 15, r0 = tid >> 4;
    AUnit cur, nxt; u32x4 kr[4], vr[4]; bf16x8 qfn[4];
    if (nsteps > 0) { attn_decode(p, 0, vb, cur); attn_issue(cur, tid, wid, q16, g, kr, vr, qfn); }
    for (int st = 0; st < nsteps; ++st) {
        if (cur.newkv) {
            const int slotC = cur.par * 128, slotP = (cur.par ^ 1) * 128;
            __syncthreads();
#pragma unroll
            for (int i = 0; i < 4; ++i) { const int row = slotC + r0 + 32 * i;
                *(LAS u32x4*)(lds + K_LDS + row * K_PITCH + ch * 16) = kr[i]; *(LAS u32x4*)(lds + V_LDS + row * V_PITCH + ch * 16) = vr[i]; }
            if (cur.first) {
                const u32x4 z = {0u, 0u, 0u, 0u};
#pragma unroll
                for (int i = 0; i < 4; ++i) *(LAS u32x4*)(lds + V_LDS + (slotP + r0 + 32 * i) * V_PITCH + ch * 16) = z;
            } else if (!cur.reuse) {
                u32x4 kp[4], vp[4];
#pragma unroll
                for (int i = 0; i < 4; ++i) { const size_t off = (size_t)((long)cur.tq0 + (long)(r0 + 32 * i - 128) * cur.d) * cur.ldk + 8 * ch;
                    kp[i] = *(const u32x4*)(cur.k + off); vp[i] = *(const u32x4*)(cur.v + off); }
#pragma unroll
                for (int i = 0; i < 4; ++i) { const int row = slotP + r0 + 32 * i;
                    *(LAS u32x4*)(lds + K_LDS + row * K_PITCH + ch * 16) = kp[i]; *(LAS u32x4*)(lds + V_LDS + row * V_PITCH + ch * 16) = vp[i]; }
            }
            __syncthreads(); }
        bf16x8 qf[4];
#pragma unroll
        for (int ks = 0; ks < 4; ++ks) qf[ks] = qfn[ks];
        if (st + 1 < nsteps) { attn_decode(p, st + 1, vb, nxt); attn_issue(nxt, tid, wid, q16, g, kr, vr, qfn); }
        const int first = cur.first, maxback = cur.maxback; const float c2 = cur.c2, sink2 = cur.sink2;
        const int qtok = cur.tq0 + (16 * wid + q16) * cur.d;
        bf16_t* qrow = cur.q + (size_t)qtok * cur.ldq;
        const int slotC = cur.par * 128, slotP = (cur.par ^ 1) * 128;
        f32x4 s[9];
#pragma unroll
        for (int t = 0; t < 9; ++t) { s[t] = (f32x4){0.f, 0.f, 0.f, 0.f};
            const int T = wid + t, rowb = ((T < 8) ? slotP : slotC) + (T & 7) * 16;
#pragma unroll
            for (int ks = 0; ks < 4; ++ks) { const bf16x8 a = *(const LAS bf16x8*)(lds + K_LDS + (rowb + q16) * K_PITCH + (32 * ks + 8 * g) * 2); s[t] = MFMA16(a, qf[ks], s[t]); } }
        float mx = -INFINITY;
#pragma unroll
        for (int t = 0; t < 9; ++t)
#pragma unroll
            for (int r = 0; r < 4; ++r) { const int rel = 128 + q16 - 16 * t - 4 * g - r, kk = 16 * (wid + t) + 4 * g + r;
                const bool valid = (rel >= 0) && (rel <= maxback) && !(first && kk < 128);
                const float v = valid ? (s[t][r] * c1 - c2 * (float)rel) : -INFINITY; s[t][r] = v; mx = fmaxf(mx, v); }
        mx = fmaxf(mx, __shfl_xor(mx, 16)); mx = fmaxf(mx, __shfl_xor(mx, 32));
        mx = fmaxf(mx, sink2);
        float sum = 0.f;
#pragma unroll
        for (int t = 0; t < 9; ++t)
#pragma unroll
            for (int r = 0; r < 4; ++r) { const float e = __builtin_amdgcn_exp2f(s[t][r] - mx); s[t][r] = e; sum += e; }
        sum += __shfl_xor(sum, 16); sum += __shfl_xor(sum, 32);
        sum += __builtin_amdgcn_exp2f(sink2 - mx);
        bf16x8 pf[5];
#pragma unroll
        for (int uu = 0; uu < 5; ++uu) { u32x4 w; w.x = cvt_pk_bf16(s[2 * uu][0], s[2 * uu][1]); w.y = cvt_pk_bf16(s[2 * uu][2], s[2 * uu][3]);
            if (uu < 4) { w.z = cvt_pk_bf16(s[2 * uu + 1][0], s[2 * uu + 1][1]); w.w = cvt_pk_bf16(s[2 * uu + 1][2], s[2 * uu + 1][3]); } else { w.z = 0u; w.w = 0u; }
            pf[uu] = __builtin_bit_cast(bf16x8, w); }
        const unsigned vcom = (unsigned)(size_t)(lds + V_LDS) + (unsigned)((4 * g + (q16 >> 2)) * V_PITCH + (q16 & 3) * 8);
        unsigned vbase[9];
#pragma unroll
        for (int t = 0; t < 9; ++t) { const int T = wid + t; vbase[t] = vcom + (unsigned)((((T < 8) ? slotP : slotC) + (T & 7) * 16) * V_PITCH); }
        const float inv = 1.0f / sum;
        s16x4 lo[2][5], hi[2][4];
#pragma unroll
        for (int uu = 0; uu < 5; ++uu) { TRRD(lo[0][uu], vbase[2 * uu], 0); if (uu < 4) TRRD(hi[0][uu], vbase[2 * uu + 1], 0); }
#pragma unroll
        for (int dt = 0; dt < 8; ++dt) {
            const int S = dt & 1;
            if (dt + 1 < 8) {
#pragma unroll
                for (int uu = 0; uu < 5; ++uu) { TRRD(lo[S ^ 1][uu], vbase[2 * uu], 32 * (dt + 1)); if (uu < 4) TRRD(hi[S ^ 1][uu], vbase[2 * uu + 1], 32 * (dt + 1)); }
                asm volatile("s_waitcnt lgkmcnt(9)" : "+v"(lo[S][0]), "+v"(lo[S][1]), "+v"(lo[S][2]), "+v"(lo[S][3]), "+v"(lo[S][4]), "+v"(hi[S][0]), "+v"(hi[S][1]), "+v"(hi[S][2]), "+v"(hi[S][3]) :: "memory");
            } else {
                asm volatile("s_waitcnt lgkmcnt(0)" : "+v"(lo[S][0]), "+v"(lo[S][1]), "+v"(lo[S][2]), "+v"(lo[S][3]), "+v"(lo[S][4]), "+v"(hi[S][0]), "+v"(hi[S][1]), "+v"(hi[S][2]), "+v"(hi[S][3]) :: "memory");
            }
            f32x4 o = (f32x4){0.f, 0.f, 0.f, 0.f};
#pragma unroll
            for (int uu = 0; uu < 5; ++uu) { const bf16x8 vf = (uu < 4) ? __builtin_shufflevector(lo[S][uu], hi[S][uu], 0, 1, 2, 3, 4, 5, 6, 7) : __builtin_shufflevector(lo[S][4], lo[S][4], 0, 1, 2, 3, 4, 5, 6, 7);
                o = MFMA16(vf, pf[uu], o); }
            u32x2 w; w.x = cvt_pk_bf16(o[0] * inv, o[1] * inv); w.y = cvt_pk_bf16(o[2] * inv, o[3] * inv);
            *(u32x2*)(qrow + 16 * dt + 4 * g) = w;
        }
        if (cur.lse && g == 0) cur.lse[(size_t)qtok * 8] = (mx + __builtin_amdgcn_logf(sum)) * LN2;
        cur = nxt;
    }
    __syncthreads();
}
__device__ __forceinline__ void combine_phase(const Params& p) {
    const bf16_t* QA = (const bf16_t*)(p.ws + WS_QA); const float* LSE = (const float*)(p.ws + WS_LSE); bf16_t* OA = (bf16_t*)((unsigned char*)p.out + DO_OA);
    const int nthr = gridDim.x * 512;
    int tid = threadIdx.x; asm volatile("" : "+v"(tid));
#pragma unroll 4
    for (int idx = blockIdx.x * 512 + tid; idx < MT * 128; idx += nthr) {
        const int tok = idx >> 7, hc = idx & 127, h = hc >> 4, c = hc & 15;
        const float l0 = LSE[((size_t)0 * MT + tok) * 8 + h], l1 = LSE[((size_t)1 * MT + tok) * 8 + h], l2 = LSE[((size_t)2 * MT + tok) * 8 + h];
        const float mx = fmaxf(l0, fmaxf(l1, l2)); float w0 = __expf(l0 - mx), w1 = __expf(l1 - mx), w2 = __expf(l2 - mx); const float inv = 1.0f / (w0 + w1 + w2); w0 *= inv; w1 *= inv; w2 *= inv;
        const bf16_t* base = QA + (size_t)tok * 3072 + h * 128 + 8 * c;
        const u32x4 a = __builtin_nontemporal_load((const u32x4*)(base)), b = __builtin_nontemporal_load((const u32x4*)(base + 1024)), cc = __builtin_nontemporal_load((const u32x4*)(base + 2048));
        u32x4 o;
#pragma unroll
        for (int j = 0; j < 4; ++j) { const float lo = w0 * bf_lo(a[j]) + w1 * bf_lo(b[j]) + w2 * bf_lo(cc[j]), hi = w0 * bf_hi(a[j]) + w1 * bf_hi(b[j]) + w2 * bf_hi(cc[j]); o[j] = cvt_pk_bf16(lo, hi); }
        *(u32x4*)(OA + (size_t)tok * 1024 + h * 128 + 8 * c) = o;
    }
}

__device__ __forceinline__ void grid_bar(unsigned* ctr, unsigned target) {
    asm volatile("s_waitcnt vmcnt(0)" ::: "memory");
    __syncthreads();
    if (threadIdx.x == 0) {
        __builtin_amdgcn_fence(__ATOMIC_RELEASE, "agent");
        asm volatile("s_waitcnt vmcnt(0)" ::: "memory");
        __hip_atomic_fetch_add(ctr, 1u, __ATOMIC_RELAXED, __HIP_MEMORY_SCOPE_AGENT);
        while (__hip_atomic_load(ctr, __ATOMIC_RELAXED, __HIP_MEMORY_SCOPE_AGENT) < target) __builtin_amdgcn_s_sleep(2);
        __builtin_amdgcn_fence(__ATOMIC_ACQUIRE, "agent");
        asm volatile("s_waitcnt vmcnt(0)" ::: "memory");
    }
    __syncthreads();
}
__global__ void __launch_bounds__(512, 2) mega(Params p) {
    extern __shared__ __attribute__((aligned(16))) unsigned char lds[];
    cg::grid_group grid = cg::this_grid();
    PG8_LAS unsigned char* L = (PG8_LAS unsigned char*)lds;
    const int G = gridDim.x, c = blockIdx.x;
    unsigned* bar = (unsigned*)(p.ws + WS_BAR); unsigned* gbar = bar + 64 * (1 + (c & 7)); const bool grouped = (G % 8 == 0);
    unsigned char* ws = p.ws; unsigned char* ob = (unsigned char*)p.out;
    bf16_t* H = (bf16_t*)(ob + DO_H); bf16_t* WtIn = (bf16_t*)(ob + DO_WIN); bf16_t* OA = (bf16_t*)(ob + DO_OA);
    bf16_t* WtBa = (bf16_t*)(ws + WS_WBA); bf16_t* WtBb = (bf16_t*)(ws + WS_WBB); bf16_t* WtOut = (bf16_t*)(ws + WS_WOUT); bf16_t* WtF1 = (bf16_t*)(ws + WS_WFF1); bf16_t* WtF2 = (bf16_t*)(ws + WS_WFF2);
    bf16_t* MRG = (bf16_t*)(ws + WS_MRG); bf16_t* H2 = (bf16_t*)(ws + WS_H2); bf16_t* ACT = (bf16_t*)(ws + WS_ACT);
    transpose_convert(p.w_in, WtIn, DM, INC, nullptr, lds);
    rmsnorm_rows(p.x, p.norm1_g, H);
    grid.sync();
    { PG8_LAS float* gl = (PG8_LAS float*)(L + pg8::STAGE_BYTES + 8192); const int t = threadIdx.x;
      gl[t] = (t < 128) ? p.qna[t] : (t < 256) ? p.kna[t - 128] : (t < 384) ? p.qnb[t - 256] : p.knb[t - 384]; __syncthreads(); }
    { pg8::Gemm g{H, WtIn, MT, INC, DM}; pg8::StaticOrder S; S.init(MT, INC, G, c, 1);
      pg8::EpiProj E{(bf16_t*)(ws + WS_QA), (bf16_t*)(ws + WS_KA), (bf16_t*)(ws + WS_VA), (bf16_t*)(ws + WS_QB), (bf16_t*)(ws + WS_KB), (bf16_t*)(ws + WS_VB), (bf16_t*)(ws + WS_GA), (bf16_t*)(ws + WS_GB)};
      pg8::gemm_phase(L, g, S, E); }
    if (G == 256) { if (c >= 128) { transpose_convert_part(p.wba, WtBa, 1024, DM, lds, c - 128, 128); transpose_convert_part(p.wbb, WtBb, DM, DM, lds, c - 128, 128); } }
    else { transpose_convert(p.wba, WtBa, 1024, DM, nullptr, lds); transpose_convert(p.wbb, WtBb, DM, DM, nullptr, lds); }
    grid_bar(bar, 1u * (unsigned)G);
    attn_phase(p, lds);
    grid_bar(bar, 2u * (unsigned)G);
    combine_phase(p);
    transpose_convert(p.wout, WtOut, DM, DM, nullptr, lds);
    transpose_convert(p.wff1, WtF1, DM, DFF, p.norm2_g, lds);
    transpose_convert(p.wff2, WtF2, DFF, DM, nullptr, lds);
    grid_bar(bar, 3u * (unsigned)G);
    { pg8::Gemm g{OA, WtBa, MT, DM, 1024}; pg8::StaticOrder S; S.init(MT, DM, G, c);
      pg8::EpiGate E{(const bf16_t*)(ws + WS_GA), nullptr, MRG, DM}; pg8::gemm_phase(L, g, S, E); }
    { pg8::Gemm g{(const bf16_t*)(ws + WS_QB), WtBb, MT, DM, DM}; pg8::StaticOrder S; S.init(MT, DM, G, c);
      pg8::EpiGate E{(const bf16_t*)(ws + WS_GB), MRG, MRG, DM}; pg8::gemm_phase(L, g, S, E); }
    if (grouped) grid_bar(gbar, 1u * (unsigned)(G >> 3)); else grid_bar(bar, 4u * (unsigned)G);
    { pg8::Gemm g{MRG, WtOut, MT, DM, DM}; pg8::StaticOrder S; S.init(MT, DM, G, c);
      pg8::EpiResX1 E{p.x, H2, (float*)(ws + WS_SSQ), DM}; pg8::gemm_phase(L, g, S, E); }
    grid_bar(bar, (grouped ? 4u : 5u) * (unsigned)G);
    { pg8::Gemm g{H2, WtF1, MT, DFF, DM}; pg8::StaticOrder S; S.init(MT, DFF, G, c, 1);
      pg8::Unit u0; if (S.next(0, u0)) { PG8_LAS float* RS = (PG8_LAS float*)(L + pg8::STAGE_BYTES + 8192 + 2048); const int t = threadIdx.x;
          if (t < 256) { const float* sp = (const float*)(ws + WS_SSQ) + (size_t)(u0.pm * 256 + t) * 8; const f32x4 p0 = *(const f32x4*)sp, p1 = *(const f32x4*)(sp + 4);
              RS[t] = rsqrtf((((p0[0] + p0[1]) + (p0[2] + p0[3])) + ((p1[0] + p1[1]) + (p1[2] + p1[3]))) * (1.0f / 2048.0f) + 1e-6f); } }
      __syncthreads();
      pg8::EpiRelu2 E{ACT, ACT_LD}; pg8::gemm_phase(L, g, S, E); }
    if (grouped) grid_bar(gbar, 2u * (unsigned)(G >> 3)); else grid_bar(bar, 6u * (unsigned)G);
    { pg8::Gemm g{ACT, WtF2, MT, DM, DFF, ACT_LD}; pg8::StaticOrder S; S.init(MT, DM, G, c);
      pg8::EpiFinal E{H2, p.out, DM}; pg8::gemm_phase(L, g, S, E); }
}

extern "C" void kernel_launch(void* const* d_in, const int* in_sizes, int n_in, void* d_out, int out_size, void* d_ws, size_t ws_size, hipStream_t stream) {
    static int grid_blocks = 0;
    if (!grid_blocks) {
        if (n_in != 14 || out_size != MT * DM || ws_size < WS_NEED) { fprintf(stderr, "kernel_launch: unexpected shapes (n_in %d out %d ws %zu)\n", n_in, out_size, ws_size); grid_blocks = -1; return; }
        int dev = 0, cus = 0, per_cu = 0;
        (void)hipGetDevice(&dev); (void)hipDeviceGetAttribute(&cus, hipDeviceAttributeMultiprocessorCount, dev);
        if (hipFuncSetAttribute((const void*)mega, hipFuncAttributeMaxDynamicSharedMemorySize, LDS_BYTES) != hipSuccess) { fprintf(stderr, "kernel_launch: hipFuncSetAttribute failed\n"); grid_blocks = -1; return; }
        (void)hipOccupancyMaxActiveBlocksPerMultiprocessor(&per_cu, (const void*)mega, 512, LDS_BYTES);
        if (per_cu < 1) { fprintf(stderr, "kernel_launch: occupancy query says %d blocks/CU\n", per_cu); }
        (void)hipGetLastError();
        if (cus % 64 != 0) { fprintf(stderr, "kernel_launch: built for a CU count that is a multiple of 64 (MI355X: 256), got %d; nothing launched\n", cus); grid_blocks = -1; return; }
        grid_blocks = cus;
    }
    if (grid_blocks < 0) return;
    Params p{};
    p.x = (const float*)d_in[0]; p.norm1_g = (const float*)d_in[1]; p.w_in = (const float*)d_in[2]; p.qna = (const float*)d_in[3]; p.kna = (const float*)d_in[4];
    p.qnb = (const float*)d_in[5]; p.knb = (const float*)d_in[6]; p.sinks = (const float*)d_in[7]; p.wba = (const float*)d_in[8]; p.wbb = (const float*)d_in[9];
    p.wout = (const float*)d_in[10]; p.norm2_g = (const float*)d_in[11]; p.wff1 = (const float*)d_in[12]; p.wff2 = (const float*)d_in[13];
    p.out = (float*)d_out; p.ws = (unsigned char*)d_ws;
    if (hipMemsetAsync((unsigned char*)d_ws + WS_BAR, 0, 4096, stream) != hipSuccess) { fprintf(stderr, "kernel_launch: memset of the barrier word failed\n"); return; }
    void* args[] = {&p};
    hipError_t e = hipLaunchCooperativeKernel((const void*)mega, dim3(grid_blocks), dim3(512), args, LDS_BYTES, stream);
    if (e != hipSuccess) fprintf(stderr, "cooperative launch failed: %s (grid %d)\n", hipGetErrorString(e), grid_blocks);
}
```

```cpp
#include <hip/hip_runtime.h>
#include <hip/hip_cooperative_groups.h>
#include <cstdio>
namespace cg = cooperative_groups;

namespace pg8 {
#define PG8_LAS __attribute__((address_space(3)))
typedef unsigned short bf16_t;
typedef short bf16x8 __attribute__((ext_vector_type(8)));
typedef float f32x4 __attribute__((ext_vector_type(4)));
typedef unsigned u32x4 __attribute__((ext_vector_type(4)));
constexpr int BM = 256, BK = 64, HALF = 128, HTB = HALF * BK * 2  , STAGE_BYTES = 8 * HTB, NXCD = 8, WGM = 8;

__host__ __device__ __forceinline__ int lds_byte(int r, int c) { const int st = (r >> 4) * 2 + (c >> 5), rr = r & 15, cc = c & 31, ob = rr * 64 + cc * 2; return st * 1024 + (ob ^ (((ob >> 9) & 1) << 5)); }
__host__ __device__ __forceinline__ void stage_rc(int b, int& R, int& C) { const int st = b / 1024, sb = b % 1024, swz = sb ^ (((sb >> 9) & 1) << 5); R = (st >> 1) * 16 + swz / 64; C = (st & 1) * 32 + (swz % 64) / 2; }
__host__ __device__ __forceinline__ int perm32(int rho) { const int n = rho >> 4, i = rho & 15; return 8 * (i >> 2) + 4 * n + (i & 3); }

struct Unit { int pm, pn; };
struct Gemm { const bf16_t* A; const bf16_t* Bt; int M, N, K; int lda = 0; };

struct StaticOrder {
    int nM, nN, nwg, G, c, flip;
    __host__ __device__ void init(int M, int N, int G_, int c_, int flip_ = 0) { nM = M / BM; nN = N / BM; nwg = nM * nN; G = G_; c = c_; flip = flip_; }
    __host__ __device__ bool next(int i, Unit& u) const {
        const long L = (long)i * G + c; if (L >= nwg) return false;
        int wgid = (int)L; { const int q = nwg / NXCD, r = nwg % NXCD, xcd = wgid % NXCD, off = wgid / NXCD; wgid = (xcd < r ? xcd * (q + 1) : r * (q + 1) + (xcd - r) * q) + off; }
        const int nig = WGM * nN, gid = wgid / nig, fm = gid * WGM, gsz = (nM - fm) < WGM ? (nM - fm) : WGM;
        u.pm = fm + ((wgid % nig) % gsz); u.pn = (wgid % nig) / gsz; if (flip) u.pn = nN - 1 - u.pn; return true;
    }
    __device__ __forceinline__ void a_ready(const Unit&) const {}
    __device__ __forceinline__ void done(const Unit&) const {}
};
__device__ __forceinline__ unsigned cvt_pk_bf16(float lo, float hi) { unsigned r; asm("v_cvt_pk_bf16_f32 %0, %1, %2" : "=v"(r) : "v"(lo), "v"(hi)); return r; }
typedef float f32x2 __attribute__((ext_vector_type(2)));
typedef unsigned u32x2 __attribute__((ext_vector_type(2)));
__device__ __forceinline__ float bf_lo(unsigned w) { return __uint_as_float(w << 16); }
__device__ __forceinline__ float bf_hi(unsigned w) { return __uint_as_float(w & 0xffff0000u); }

struct EpiProj {
    static constexpr bool PERM = true, AFTER_DRAIN = false;
    bf16_t *QA, *KA, *VA, *QB, *KB, *VB, *GA, *GB;
    __device__ __forceinline__ void operator()(const f32x4 (&acc)[2][2][4][2], const Unit& u, int wr, int wc, int fr, int fq, PG8_LAS unsigned char* xl) const {
        const int pn = u.pn; int mode, ldc, colt; bf16_t* base; int gsel = 0;
        if (pn < 12)       { mode = 1; base = QA; ldc = 3072; colt = pn * 256; gsel = 0; }
        else if (pn < 24)  { mode = 1; base = KA; ldc = 3072; colt = (pn - 12) * 256; gsel = 1; }
        else if (pn < 36)  { mode = 0; base = VA; ldc = 3072; colt = (pn - 24) * 256; }
        else if (pn < 44)  { mode = 1; base = QB; ldc = 2048; colt = (pn - 36) * 256; gsel = 2; }
        else if (pn == 44) { mode = 1; base = KB; ldc = 256; colt = 0; gsel = 3; }
        else if (pn == 45) { mode = 0; base = VB; ldc = 256; colt = 0; }
        else if (pn < 54)  { mode = 2; base = GA; ldc = 2048; colt = (pn - 46) * 256; }
        else               { mode = 2; base = GB; ldc = 2048; colt = (pn - 54) * 256; }
        const int row0 = u.pm * BM + wr * 64 + fr, col0 = colt + wc * 32 + 8 * fq;
        if (mode == 1) {
            PG8_LAS float* T = (PG8_LAS float*)xl;
#pragma unroll
            for (int ai = 0; ai < 2; ++ai)
#pragma unroll
                for (int m = 0; m < 4; ++m)
#pragma unroll
                    for (int bj = 0; bj < 2; ++bj) {
                        const f32x4 a = acc[ai][bj][m][0], b = acc[ai][bj][m][1];
                        float s = (a[0] * a[0] + a[1] * a[1]) + (a[2] * a[2] + a[3] * a[3]) + (b[0] * b[0] + b[1] * b[1]) + (b[2] * b[2] + b[3] * b[3]);
                        s += __shfl_xor(s, 16); s += __shfl_xor(s, 32);
                        if (fq == 0) T[((ai * HALF + wr * 64 + m * 16 + fr) * 2 + bj) * 4 + wc] = s;
                    }
            asm volatile("s_waitcnt lgkmcnt(0)" ::: "memory"); __builtin_amdgcn_s_barrier(); asm volatile("" ::: "memory");
            const PG8_LAS float* gl = (const PG8_LAS float*)(xl + 8192) + gsel * 128 + wc * 32 + 8 * fq;
            const f32x4 g0 = *(const PG8_LAS f32x4*)gl, g1 = *(const PG8_LAS f32x4*)(gl + 4);
#pragma unroll
            for (int ai = 0; ai < 2; ++ai)
#pragma unroll
                for (int m = 0; m < 4; ++m) { bf16_t* rowp = base + (size_t)(row0 + ai * HALF + m * 16) * ldc + col0;
#pragma unroll
                    for (int bj = 0; bj < 2; ++bj) {
                        const f32x4 t = *(const PG8_LAS f32x4*)(T + ((ai * HALF + wr * 64 + m * 16 + fr) * 2 + bj) * 4);
                        const float rs = rsqrtf(((t[0] + t[1]) + (t[2] + t[3])) * (1.0f / 128.0f) + 1e-6f);
                        const f32x4 v0 = acc[ai][bj][m][0] * rs * g0, v1 = acc[ai][bj][m][1] * rs * g1;
                        u32x4 w; w.x = cvt_pk_bf16(v0[0], v0[1]); w.y = cvt_pk_bf16(v0[2], v0[3]); w.z = cvt_pk_bf16(v1[0], v1[1]); w.w = cvt_pk_bf16(v1[2], v1[3]);
                        *(u32x4*)(rowp + bj * HALF) = w; } }
        } else {
#pragma unroll
            for (int ai = 0; ai < 2; ++ai)
#pragma unroll
                for (int m = 0; m < 4; ++m) { bf16_t* rowp = base + (size_t)(row0 + ai * HALF + m * 16) * ldc + col0;
#pragma unroll
                    for (int bj = 0; bj < 2; ++bj) { f32x4 v0 = acc[ai][bj][m][0], v1 = acc[ai][bj][m][1];
                        if (mode == 2) {
#pragma unroll
                            for (int j = 0; j < 4; ++j) { v0[j] = __builtin_amdgcn_rcpf(1.0f + __expf(-v0[j])); v1[j] = __builtin_amdgcn_rcpf(1.0f + __expf(-v1[j])); } }
                        u32x4 w; w.x = cvt_pk_bf16(v0[0], v0[1]); w.y = cvt_pk_bf16(v0[2], v0[3]); w.z = cvt_pk_bf16(v1[0], v1[1]); w.w = cvt_pk_bf16(v1[2], v1[3]);
                        if (mode == 2) __builtin_nontemporal_store(w, (u32x4*)(rowp + bj * HALF)); else *(u32x4*)(rowp + bj * HALF) = w; } }
        }
    }
};
struct EpiGate {
    static constexpr bool PERM = true, AFTER_DRAIN = false;
    const bf16_t* G; const bf16_t* addend; bf16_t* out; int ldc;
    __device__ __forceinline__ void operator()(const f32x4 (&acc)[2][2][4][2], const Unit& u, int wr, int wc, int fr, int fq, PG8_LAS unsigned char*) const {
        const int row0 = u.pm * BM + wr * 64 + fr, col0 = u.pn * BM + wc * 32 + 8 * fq;
#pragma unroll
        for (int ai = 0; ai < 2; ++ai)
#pragma unroll
            for (int m = 0; m < 4; ++m) { const size_t roff = (size_t)(row0 + ai * HALF + m * 16) * ldc + col0;
#pragma unroll
                for (int bj = 0; bj < 2; ++bj) { const size_t off = roff + bj * HALF;
                    const u32x4 gw = __builtin_nontemporal_load((const u32x4*)(G + off));     f32x4 v0 = acc[ai][bj][m][0], v1 = acc[ai][bj][m][1];
                    v0[0] *= bf_lo(gw.x); v0[1] *= bf_hi(gw.x); v0[2] *= bf_lo(gw.y); v0[3] *= bf_hi(gw.y);
                    v1[0] *= bf_lo(gw.z); v1[1] *= bf_hi(gw.z); v1[2] *= bf_lo(gw.w); v1[3] *= bf_hi(gw.w);
                    if (addend) { const u32x4 aw = *(const u32x4*)(addend + off);
                        v0[0] += bf_lo(aw.x); v0[1] += bf_hi(aw.x); v0[2] += bf_lo(aw.y); v0[3] += bf_hi(aw.y);
                        v1[0] += bf_lo(aw.z); v1[1] += bf_hi(aw.z); v1[2] += bf_lo(aw.w); v1[3] += bf_hi(aw.w); }
                    u32x4 w; w.x = cvt_pk_bf16(v0[0], v0[1]); w.y = cvt_pk_bf16(v0[2], v0[3]); w.z = cvt_pk_bf16(v1[0], v1[1]); w.w = cvt_pk_bf16(v1[2], v1[3]);
                    *(u32x4*)(out + off) = w; } }
    }
};
struct EpiResF32 {
    static constexpr bool PERM = true, AFTER_DRAIN = false;
    const float* res; float* out; int ldc;
    __device__ __forceinline__ void operator()(const f32x4 (&acc)[2][2][4][2], const Unit& u, int wr, int wc, int fr, int fq, PG8_LAS unsigned char*) const {
        const int row0 = u.pm * BM + wr * 64 + fr, col0 = u.pn * BM + wc * 32 + 8 * fq;
#pragma unroll
        for (int ai = 0; ai < 2; ++ai)
#pragma unroll
            for (int m = 0; m < 4; ++m) { const size_t roff = (size_t)(row0 + ai * HALF + m * 16) * ldc + col0;
#pragma unroll
                for (int bj = 0; bj < 2; ++bj)
#pragma unroll
                    for (int n = 0; n < 2; ++n) { const size_t off = roff + bj * HALF + n * 4; const f32x4 r = *(const f32x4*)(res + off); *(f32x4*)(out + off) = r + acc[ai][bj][m][n]; } }
    }
};
struct EpiResX1 {
    static constexpr bool PERM = true, AFTER_DRAIN = false;
    const float* res; bf16_t* xb; float* ssqp; int ldc;
    __device__ __forceinline__ void operator()(const f32x4 (&acc)[2][2][4][2], const Unit& u, int wr, int wc, int fr, int fq, PG8_LAS unsigned char* xl) const {
        const int row0 = u.pm * BM + wr * 64 + fr, col0 = u.pn * BM + wc * 32 + 8 * fq;
        PG8_LAS float* T = (PG8_LAS float*)xl;
#pragma unroll
        for (int ai = 0; ai < 2; ++ai)
#pragma unroll
            for (int m = 0; m < 4; ++m) { const size_t roff = (size_t)(row0 + ai * HALF + m * 16) * ldc + col0; float s = 0.f;
#pragma unroll
                for (int bj = 0; bj < 2; ++bj) { const size_t off = roff + bj * HALF;
                    const f32x4 v0 = __builtin_nontemporal_load((const f32x4*)(res + off)) + acc[ai][bj][m][0], v1 = __builtin_nontemporal_load((const f32x4*)(res + off + 4)) + acc[ai][bj][m][1];
                    u32x4 w; w.x = cvt_pk_bf16(v0[0], v0[1]); w.y = cvt_pk_bf16(v0[2], v0[3]); w.z = cvt_pk_bf16(v1[0], v1[1]); w.w = cvt_pk_bf16(v1[2], v1[3]);
                    *(u32x4*)(xb + off) = w;
                    s += (v0[0] * v0[0] + v0[1] * v0[1]) + (v0[2] * v0[2] + v0[3] * v0[3]) + (v1[0] * v1[0] + v1[1] * v1[1]) + (v1[2] * v1[2] + v1[3] * v1[3]); }
                s += __shfl_xor(s, 16); s += __shfl_xor(s, 32);
                if (fq == 0) T[(ai * HALF + wr * 64 + m * 16 + fr) * 4 + wc] = s; }
        asm volatile("s_waitcnt lgkmcnt(0)" ::: "memory"); __builtin_amdgcn_s_barrier(); asm volatile("" ::: "memory");
        if (wc == 0 && fq == 0) {
#pragma unroll
            for (int ai = 0; ai < 2; ++ai)
#pragma unroll
                for (int m = 0; m < 4; ++m) { const int r = ai * HALF + wr * 64 + m * 16 + fr; const f32x4 t = *(const PG8_LAS f32x4*)(T + r * 4);
                    ssqp[(size_t)(u.pm * BM + r) * 8 + u.pn] = (t[0] + t[1]) + (t[2] + t[3]); } }
    }
};
struct EpiFinal {
    static constexpr bool PERM = true, AFTER_DRAIN = false;
    const bf16_t* res; float* out; int ldc;
    __device__ __forceinline__ void operator()(const f32x4 (&acc)[2][2][4][2], const Unit& u, int wr, int wc, int fr, int fq, PG8_LAS unsigned char*) const {
        const int row0 = u.pm * BM + wr * 64 + fr, col0 = u.pn * BM + wc * 32 + 8 * fq;
#pragma unroll
        for (int ai = 0; ai < 2; ++ai)
#pragma unroll
            for (int m = 0; m < 4; ++m) { const size_t roff = (size_t)(row0 + ai * HALF + m * 16) * ldc + col0;
#pragma unroll
                for (int bj = 0; bj < 2; ++bj) { const size_t off = roff + bj * HALF; const u32x4 rw = __builtin_nontemporal_load((const u32x4*)(res + off));
                    f32x4 v0 = acc[ai][bj][m][0], v1 = acc[ai][bj][m][1];
                    v0[0] += bf_lo(rw.x); v0[1] += bf_hi(rw.x); v0[2] += bf_lo(rw.y); v0[3] += bf_hi(rw.y);
                    v1[0] += bf_lo(rw.z); v1[1] += bf_hi(rw.z); v1[2] += bf_lo(rw.w); v1[3] += bf_hi(rw.w);
                    __builtin_nontemporal_store(v0, (f32x4*)(out + off)); __builtin_nontemporal_store(v1, (f32x4*)(out + off + 4)); } }
    }
};
struct EpiRelu2 {
    static constexpr bool PERM = true, AFTER_DRAIN = false;
    bf16_t* out; int ldc;
    __device__ __forceinline__ void operator()(const f32x4 (&acc)[2][2][4][2], const Unit& u, int wr, int wc, int fr, int fq, PG8_LAS unsigned char* xl) const {
        const int row0 = u.pm * BM + wr * 64 + fr, col0 = u.pn * BM + wc * 32 + 8 * fq;
        const PG8_LAS float* RS = (const PG8_LAS float*)(xl + 8192 + 2048);
#pragma unroll
        for (int ai = 0; ai < 2; ++ai)
#pragma unroll
            for (int m = 0; m < 4; ++m) { const int rl = wr * 64 + fr + ai * HALF + m * 16; bf16_t* rowp = out + (size_t)(u.pm * BM + rl) * ldc + col0;
                const float rs = RS[rl];
#pragma unroll
                for (int bj = 0; bj < 2; ++bj) { f32x4 v0 = acc[ai][bj][m][0], v1 = acc[ai][bj][m][1];
#pragma unroll
                    for (int j = 0; j < 4; ++j) { const float a = fmaxf(v0[j] * rs, 0.f), b = fmaxf(v1[j] * rs, 0.f); v0[j] = a * a; v1[j] = b * b; }
                    u32x4 w; w.x = cvt_pk_bf16(v0[0], v0[1]); w.y = cvt_pk_bf16(v0[2], v0[3]); w.z = cvt_pk_bf16(v1[0], v1[1]); w.w = cvt_pk_bf16(v1[2], v1[3]);
                    *(u32x4*)(rowp + bj * HALF) = w; } }
    }
};

template <class Epi, class Sched>
__device__ __forceinline__ void gemm_phase(PG8_LAS unsigned char* lds, const Gemm g, const Sched& S, const Epi& E) {
    int tid = threadIdx.x; asm volatile("" : "+v"(tid));
    const int wid = __builtin_amdgcn_readfirstlane(tid >> 6), lane = tid & 63, wr = wid >> 2, wc = wid & 3, fr = lane & 15, fq = lane >> 4;
    const int K = g.K, nt = K / BK;
    const int lda = g.lda ? g.lda : K;
    unsigned voffA[2], voffB[2];
#pragma unroll
    for (int i = 0; i < 2; ++i) { int R, C; stage_rc(tid * 16 + i * 8192, R, C); const int Rb = Epi::PERM ? ((R & ~31) + perm32(R & 31)) : R;
        voffA[i] = (unsigned)(R * lda + C) * 2u; voffB[i] = (unsigned)(Rb * K + C) * 2u; }
    const size_t kstep = (size_t)(BK * 2);
    const size_t hstepA = (size_t)HALF * lda * 2, hstepB = (size_t)HALF * K * 2;
    const size_t tstepA = 2 * hstepA, tstepB = 2 * hstepB;
    const unsigned ldsw = (unsigned)wid * 1024u;
    const int aoff = lds_byte(wr * 64 + fr, fq * 8), boff = lds_byte(wc * 32 + fr, fq * 8);
#define PG8_SA(b, h) (((b) * 2 + (h)) * HTB)
#define PG8_SB(b, h) ((4 + (b) * 2 + (h)) * HTB)
#define PG8_STAGE(bufoff, gbase, voff) do { _Pragma("unroll") for (int _i = 0; _i < 2; ++_i) \
        __builtin_amdgcn_global_load_lds((const unsigned*)((const char*)(gbase) + (voff)[_i]), (PG8_LAS unsigned*)(lds + (bufoff) + ldsw + _i * 8192), 16, 0, 0); } while (0)
#define PG8_LDA(dst, b, h) do { _Pragma("unroll") for (int m = 0; m < 4; ++m) _Pragma("unroll") for (int k = 0; k < 2; ++k) dst[m][k] = *(const PG8_LAS bf16x8*)(lds + PG8_SA(b, h) + aoff + m * 2048 + k * 1024); } while (0)
#define PG8_LDB(dst, b, h) do { _Pragma("unroll") for (int n = 0; n < 2; ++n) _Pragma("unroll") for (int k = 0; k < 2; ++k) dst[n][k] = *(const PG8_LAS bf16x8*)(lds + PG8_SB(b, h) + boff + n * 2048 + k * 1024); } while (0)
#define PG8_MMA(ai, bj, At, Bt) do { __builtin_amdgcn_s_setprio(1); _Pragma("unroll") for (int m = 0; m < 4; ++m) _Pragma("unroll") for (int n = 0; n < 2; ++n) _Pragma("unroll") for (int k = 0; k < 2; ++k) \
        acc[ai][bj][m][n] = __builtin_amdgcn_mfma_f32_16x16x32_bf16(Bt[n][k], At[m][k], acc[ai][bj][m][n], 0, 0, 0); __builtin_amdgcn_s_setprio(0); } while (0)
#define PG8_WAIT_V(n) asm volatile("s_waitcnt vmcnt(" #n ")" ::: "memory")
#define PG8_WAIT_L(n) asm volatile("s_waitcnt lgkmcnt(" #n ")" ::: "memory")
#define PG8_BAR __builtin_amdgcn_s_barrier()
#define PG8_SCHED __builtin_amdgcn_sched_barrier(0)
    Unit cur, nxt; int ui = 0;
    if (!S.next(0, cur)) return;
    f32x4 acc[2][2][4][2];
#pragma unroll
    for (int a = 0; a < 2; ++a)
#pragma unroll
        for (int b = 0; b < 2; ++b)
#pragma unroll
            for (int m = 0; m < 4; ++m)
#pragma unroll
                for (int n = 0; n < 2; ++n) acc[a][b][m][n] = (f32x4){0.f, 0.f, 0.f, 0.f};
    bf16x8 At[4][2], B0[2][2], B1[2][2];
    const char* cA = (const char*)g.A + (size_t)cur.pm * tstepA; const char* cB = (const char*)g.Bt + (size_t)cur.pn * tstepB;
    S.a_ready(cur);
    PG8_STAGE(PG8_SB(0, 0), cB, voffB); PG8_STAGE(PG8_SA(0, 0), cA, voffA); PG8_STAGE(PG8_SB(0, 1), cB + hstepB, voffB); PG8_STAGE(PG8_SA(0, 1), cA + hstepA, voffA);
    if (wr == 1) PG8_BAR;
    PG8_WAIT_V(4); PG8_BAR;
    PG8_STAGE(PG8_SB(1, 0), cB + kstep, voffB); PG8_STAGE(PG8_SA(1, 0), cA + kstep, voffA); PG8_STAGE(PG8_SB(1, 1), cB + hstepB + kstep, voffB);
    PG8_WAIT_V(6); PG8_BAR;
    for (;;) {
        const bool has_next = S.next(ui + 1, nxt);
        const char* nA = has_next ? (const char*)g.A + (size_t)nxt.pm * tstepA : cA; const char* nB = has_next ? (const char*)g.Bt + (size_t)nxt.pn * tstepB : cB;
        for (int t = 0; t < nt; t += 2) {
            const bool last = (t == nt - 2);
            const char* a1 = cA + (size_t)(t + 1) * kstep;
            const char* a2 = last ? nA : cA + (size_t)(t + 2) * kstep; const char* b2 = last ? nB : cB + (size_t)(t + 2) * kstep;
            const char* a3 = a2 + kstep; const char* b3 = b2 + kstep;
            if (last && has_next) S.a_ready(nxt);
            PG8_LDB(B0, 0, 0); PG8_SCHED; PG8_LDA(At, 0, 0); PG8_STAGE(PG8_SA(1, 1), a1 + hstepA, voffA);
            PG8_WAIT_L(8); PG8_BAR; PG8_WAIT_L(0); PG8_MMA(0, 0, At, B0); PG8_BAR; PG8_SCHED;
            PG8_LDB(B1, 0, 1); PG8_STAGE(PG8_SB(0, 0), b2, voffB);
            PG8_BAR; PG8_WAIT_L(0); PG8_MMA(0, 1, At, B1); PG8_BAR;
            PG8_LDA(At, 0, 1); PG8_STAGE(PG8_SA(0, 0), a2, voffA);
            PG8_BAR; PG8_WAIT_L(0); PG8_MMA(1, 0, At, B0); PG8_BAR; PG8_SCHED;
            PG8_STAGE(PG8_SB(0, 1), b2 + hstepB, voffB);
            PG8_WAIT_V(6); PG8_BAR; PG8_MMA(1, 1, At, B1); PG8_BAR;
            PG8_LDB(B0, 1, 0); PG8_SCHED; PG8_LDA(At, 1, 0); PG8_STAGE(PG8_SA(0, 1), a2 + hstepA, voffA);
            PG8_WAIT_L(8); PG8_BAR; PG8_WAIT_L(0); PG8_MMA(0, 0, At, B0); PG8_BAR; PG8_SCHED;
            PG8_LDB(B1, 1, 1); PG8_STAGE(PG8_SB(1, 0), b3, voffB);
            PG8_BAR; PG8_WAIT_L(0); PG8_MMA(0, 1, At, B1); PG8_BAR;
            PG8_LDA(At, 1, 1); PG8_STAGE(PG8_SA(1, 0), a3, voffA);
            PG8_BAR; PG8_WAIT_L(0); PG8_MMA(1, 0, At, B0); PG8_BAR; PG8_SCHED;
            PG8_STAGE(PG8_SB(1, 1), b3 + hstepB, voffB);
            PG8_WAIT_V(6); PG8_BAR; PG8_MMA(1, 1, At, B1); PG8_BAR;
        }
        E(acc, cur, wr, wc, fr, fq, lds + STAGE_BYTES); S.done(cur);
        if (!has_next) break;
#pragma unroll
        for (int a = 0; a < 2; ++a)
#pragma unroll
            for (int b = 0; b < 2; ++b)
#pragma unroll
                for (int m = 0; m < 4; ++m)
#pragma unroll
                    for (int n = 0; n < 2; ++n) acc[a][b][m][n] = (f32x4){0.f, 0.f, 0.f, 0.f};
        cur = nxt; cA = nA; cB = nB; ++ui;
    }
    PG8_WAIT_V(0);
    if (wr == 0) PG8_BAR;
    PG8_BAR;
#undef PG8_SA
#undef PG8_SB
#undef PG8_STAGE
#undef PG8_LDA
#undef PG8_LDB
#undef PG8_MMA
#undef PG8_WAIT_V
#undef PG8_WAIT_L
#undef PG8_BAR
#undef PG8_SCHED
}
}

using pg8::bf16_t; using pg8::bf16x8; using pg8::f32x4; using pg8::u32x4; using pg8::u32x2; using pg8::cvt_pk_bf16; using pg8::bf_lo; using pg8::bf_hi;
#define LAS __attribute__((address_space(3)))
typedef short s16x4 __attribute__((ext_vector_type(4)));
constexpr int MT = 16384, TSEQ = 8192, DM = 2048, INC = 15872, DFF = 8192, ACT_LD = DFF + 64;
constexpr size_t MiB = (size_t)1 << 20;
constexpr size_t WS_KA = 0, WS_QA = 96 * MiB, WS_VA = 192 * MiB, WS_QB = 288 * MiB, WS_KB = 352 * MiB, WS_VB = 360 * MiB, WS_GA = 368 * MiB, WS_GB = 432 * MiB,
                 WS_WBA = 496 * MiB, WS_WBB = 500 * MiB, WS_LSE = 508 * MiB, WS_SSQ = 510 * MiB, WS_BAR = 511 * MiB, WS_NEED = 512 * MiB;
constexpr size_t WS_WOUT = 0, WS_WFF1 = 8 * MiB, WS_WFF2 = 40 * MiB;
constexpr size_t WS_MRG = WS_VA, WS_H2 = WS_QA, WS_ACT = 192 * MiB;
constexpr size_t DO_H = 0, DO_WIN = 64 * MiB, DO_OA = 0;
constexpr int LDS_BYTES = 144 * 1024;
constexpr int K_PITCH = 272, V_PITCH = 288, K_LDS = 0, V_LDS = 256 * K_PITCH;

struct Params {
    const float *x, *norm1_g, *w_in, *qna, *kna, *qnb, *knb, *sinks, *wba, *wbb, *wout, *norm2_g, *wff1, *wff2;
    float* out; unsigned char* ws;
};

#define TRRD(dst, base, off) asm volatile("ds_read_b64_tr_b16 %0, %1 offset:%2" : "=&v"(dst) : "v"(base), "i"(off) : "memory")
__device__ __forceinline__ void transpose_convert_impl(const float* __restrict__ W, bf16_t* __restrict__ Wt, int K, int N, const float* __restrict__ kgain, unsigned char* lds_g, const int t_first, const int t_stride) {
    LAS unsigned char* lds = (LAS unsigned char*)lds_g;
    int tid = threadIdx.x; asm volatile("" : "+v"(tid));
    const int lane = tid & 63, w = tid >> 6, c = tid & 31, r = tid >> 5;
    const int tiles_n = N >> 7, nt = tiles_n * (K >> 7);
    const int gg = lane >> 4, i16 = lane & 15, q = i16 >> 2, pp = i16 & 3;
    const int nb = 2 * (w & 3) + (gg & 1), kb0 = (gg >> 1) + 8 * (w >> 2);
    const unsigned rd = (unsigned)(size_t)lds + (unsigned)((8 * kb0 + q) * 320 + (16 * nb + 4 * pp) * 2);
    f32x4 v[8];
    int t = t_first;
    if (t < nt) { const int tk = t / tiles_n, tn = t - tk * tiles_n; const float* src = W + (size_t)((tk << 7) + r) * N + (tn << 7) + 4 * c;
#pragma unroll
        for (int i = 0; i < 8; ++i) v[i] = __builtin_nontemporal_load((const f32x4*)(src + (size_t)(16 * i) * N));     }
    for (; t < nt; t += t_stride) {
        const int tk = t / tiles_n, tn = t - tk * tiles_n, k0 = tk << 7, n0 = tn << 7;
#pragma unroll
        for (int i = 0; i < 8; ++i) { const float g = kgain ? kgain[k0 + r + 16 * i] : 1.0f; u32x2 wv; wv.x = cvt_pk_bf16(v[i][0] * g, v[i][1] * g); wv.y = cvt_pk_bf16(v[i][2] * g, v[i][3] * g);
            *(LAS u32x2*)(lds + (r + 16 * i) * 320 + 8 * c) = wv; }
        const int t2 = t + t_stride;
        if (t2 < nt) { const int tk2 = t2 / tiles_n, tn2 = t2 - tk2 * tiles_n; const float* src = W + (size_t)((tk2 << 7) + r) * N + (tn2 << 7) + 4 * c;
#pragma unroll
            for (int i = 0; i < 8; ++i) v[i] = __builtin_nontemporal_load((const f32x4*)(src + (size_t)(16 * i) * N));     }
        __syncthreads();
        s16x4 lo[4], hi[4];
#pragma unroll
        for (int jj = 0; jj < 4; ++jj) { TRRD(lo[jj], rd, (16 * jj) * 320); TRRD(hi[jj], rd, (16 * jj + 4) * 320); }
        asm volatile("s_waitcnt lgkmcnt(0)" : "+v"(lo[0]), "+v"(lo[1]), "+v"(lo[2]), "+v"(lo[3]), "+v"(hi[0]), "+v"(hi[1]), "+v"(hi[2]), "+v"(hi[3]) :: "memory");
        bf16_t* dst = Wt + (size_t)(n0 + 16 * nb + i16) * K + k0 + 8 * kb0;
#pragma unroll
        for (int jj = 0; jj < 4; ++jj) *(bf16x8*)(dst + 16 * jj) = __builtin_shufflevector(lo[jj], hi[jj], 0, 1, 2, 3, 4, 5, 6, 7);
        __syncthreads();
    }
}
__device__ __forceinline__ void transpose_convert(const float* __restrict__ W, bf16_t* __restrict__ Wt, int K, int N, const float* __restrict__ kgain, unsigned char* lds_g) { transpose_convert_impl(W, Wt, K, N, kgain, lds_g, (int)blockIdx.x, (int)gridDim.x); }
__device__ __forceinline__ void transpose_convert_part(const float* __restrict__ W, bf16_t* __restrict__ Wt, int K, int N, unsigned char* lds_g, int first, int stride) { transpose_convert_impl(W, Wt, K, N, nullptr, lds_g, first, stride); }
__device__ __forceinline__ void rmsnorm_rows(const float* X, const float* __restrict__ g, bf16_t* H) {
    int tid = threadIdx.x; asm volatile("" : "+v"(tid));
    const int lane = tid & 63, wv = blockIdx.x * 8 + (tid >> 6), nw = gridDim.x * 8;
    f32x4 v[8], vn[8];
    if (wv < MT) { const f32x4* xr = (const f32x4*)(X + (size_t)wv * DM);
#pragma unroll
        for (int i = 0; i < 8; ++i) vn[i] = __builtin_nontemporal_load(xr + lane + 64 * i); }
    for (int row = wv; row < MT; row += nw) {
        float s = 0.f;
#pragma unroll
        for (int i = 0; i < 8; ++i) { v[i] = vn[i]; s += (v[i][0] * v[i][0] + v[i][1] * v[i][1]) + (v[i][2] * v[i][2] + v[i][3] * v[i][3]); }
        if (row + nw < MT) { const f32x4* xr = (const f32x4*)(X + (size_t)(row + nw) * DM);
#pragma unroll
            for (int i = 0; i < 8; ++i) vn[i] = __builtin_nontemporal_load(xr + lane + 64 * i); }
#pragma unroll
        for (int o = 32; o >= 1; o >>= 1) s += __shfl_xor(s, o);
        const float rs = rsqrtf(s * (1.0f / DM) + 1e-6f);
#pragma unroll
        for (int i = 0; i < 8; ++i) { const f32x4 gg = ((const f32x4*)g)[lane + 64 * i]; const f32x4 y = v[i] * rs * gg;
            u32x2 w; w.x = cvt_pk_bf16(y[0], y[1]); w.y = cvt_pk_bf16(y[2], y[3]); *(u32x2*)(H + (size_t)row * DM + 4 * (lane + 64 * i)) = w; }
    }
}
#define MFMA16(a, b, c) __builtin_amdgcn_mfma_f32_16x16x32_bf16((a), (b), (c), 0, 0, 0)
struct AUnit { bf16_t* q; const bf16_t* k; const bf16_t* v; float* lse; int ldq, ldk, d, tq0, first, maxback, newkv, reuse, par; float c2, sink2; };
__device__ __forceinline__ void attn_decode(const Params& p, int step, int vb, AUnit& a) {
    const float LOG2E = 1.4426950408889634f;
    const int G = gridDim.x; const bool packed = (G == 256);
    const int u = packed ? (step < 12 ? 12 * vb + step : 3072 + (step - 12) * 256 + vb) : vb + G * step;
    bf16_t* QA = (bf16_t*)(p.ws + WS_QA); const bf16_t* KA = (const bf16_t*)(p.ws + WS_KA); const bf16_t* VA = (const bf16_t*)(p.ws + WS_VA);
    bf16_t* QB = (bf16_t*)(p.ws + WS_QB); const bf16_t* KB = (const bf16_t*)(p.ws + WS_KB); const bf16_t* VB = (const bf16_t*)(p.ws + WS_VB);
    int hidx;
    a.par = step & 1;
    if (u < 3072) { const int b = u / 1536, rem = u - b * 1536, grp = rem >> 9, h = (rem >> 6) & 7, jr = rem & 63;
        a.d = 1 << (2 * grp); const int nb = 64 >> (2 * grp), r = jr / nb, jb = jr - r * nb;
        a.tq0 = jb * 128 * a.d + r; a.first = (jb == 0);
        const size_t hoff = (size_t)b * TSEQ * 3072 + (size_t)(grp * 8 + h) * 128;
        a.q = QA + hoff; a.k = KA + hoff; a.v = VA + hoff; a.ldq = 3072; a.ldk = 3072; hidx = 16 + grp * 8 + h; a.maxback = 128; a.sink2 = -INFINITY;
        a.lse = (float*)(p.ws + WS_LSE) + ((size_t)grp * MT + (size_t)b * TSEQ) * 8 + h; a.newkv = 1;
        a.reuse = (packed && step > 0 && jb != 0);
    } else { const int u2 = u - 3072, qh = u2 >> 8, sup = u2 & 255, j = sup & 63, kvh = (sup >> 6) & 1, b = sup >> 7;
        a.d = 1; a.tq0 = j * 128; a.first = (j == 0);
        a.q = QB + (size_t)b * TSEQ * 2048 + (size_t)(kvh * 8 + qh) * 128; a.ldq = 2048;
        a.k = KB + (size_t)b * TSEQ * 256 + (size_t)kvh * 128; a.v = VB + (size_t)b * TSEQ * 256 + (size_t)kvh * 128; a.ldk = 256;
        hidx = kvh * 8 + qh; a.maxback = 127; a.sink2 = p.sinks[hidx] * LOG2E; a.lse = nullptr; a.newkv = (qh == 0) || !packed; a.reuse = 0;
        if (packed) a.par = 0; }
    a.c2 = exp2f(-0.2f * (float)(hidx + 1)) * (float)a.d * LOG2E;
}
__device__ __forceinline__ void attn_issue(const AUnit& a, int tid, int wid, int q16, int g, u32x4 (&kr)[4], u32x4 (&vr)[4], bf16x8 (&qf)[4]) {
    const int ch = tid & 15, r0 = tid >> 4;
    if (a.newkv) {
#pragma unroll
        for (int i = 0; i < 4; ++i) { const size_t off = (size_t)(a.tq0 + (r0 + 32 * i) * a.d) * a.ldk + 8 * ch;
            kr[i] = *(const u32x4*)(a.k + off); vr[i] = *(const u32x4*)(a.v + off); } }
    const bf16_t* qrow = a.q + (size_t)(a.tq0 + (16 * wid + q16) * a.d) * a.ldq;
#pragma unroll
    for (int ks = 0; ks < 4; ++ks) qf[ks] = *(const bf16x8*)(qrow + 32 * ks + 8 * g);
}
__device__ __forceinline__ void attn_phase(const Params& p, unsigned char* lds_g) {
    LAS unsigned char* lds = (LAS unsigned char*)lds_g;
    int tid = threadIdx.x; asm volatile("" : "+v"(tid));
    const int lane = tid & 63, wid = __builtin_amdgcn_readfirstlane(tid >> 6), q16 = lane & 15, g = lane >> 4;
    const int G = gridDim.x, vb = (G % 8 == 0) ? ((int)(blockIdx.x & 7) * (G >> 3) + (int)(blockIdx.x >> 3)) : (int)blockIdx.x;
    const int nsteps = (G == 256) ? 20 : (5120 - vb + G - 1) / G;
    const float LN2 = 0.6931471805599453f;
    const float c1 = 0.08838834764831845f * 1.4426950408889634f;
    const int ch = tid & 15, r0 = tid >> 4;
    AUnit cur, nxt; u32x4 kr[4], vr[4]; bf16x8 qfn[4];
    if (nsteps > 0) { attn_decode(p, 0, vb, cur); attn_issue(cur, tid, wid, q16, g, kr, vr, qfn); }
    for (int st = 0; st < nsteps; ++st) {
        if (cur.newkv) {
            const int slotC = cur.par * 128, slotP = (cur.par ^ 1) * 128;
            __syncthreads();
#pragma unroll
            for (int i = 0; i < 4; ++i) { const int row = slotC + r0 + 32 * i;
                *(LAS u32x4*)(lds + K_LDS + row * K_PITCH + ch * 16) = kr[i]; *(LAS u32x4*)(lds + V_LDS + row * V_PITCH + ch * 16) = vr[i]; }
            if (cur.first) {
                const u32x4 z = {0u, 0u, 0u, 0u};
#pragma unroll
                for (int i = 0; i < 4; ++i) *(LAS u32x4*)(lds + V_LDS + (slotP + r0 + 32 * i) * V_PITCH + ch * 16) = z;
            } else if (!cur.reuse) {
                u32x4 kp[4], vp[4];
#pragma unroll
                for (int i = 0; i < 4; ++i) { const size_t off = (size_t)((long)cur.tq0 + (long)(r0 + 32 * i - 128) * cur.d) * cur.ldk + 8 * ch;
                    kp[i] = *(const u32x4*)(cur.k + off); vp[i] = *(const u32x4*)(cur.v + off); }
#pragma unroll
                for (int i = 0; i < 4; ++i) { const int row = slotP + r0 + 32 * i;
                    *(LAS u32x4*)(lds + K_LDS + row * K_PITCH + ch * 16) = kp[i]; *(LAS u32x4*)(lds + V_LDS + row * V_PITCH + ch * 16) = vp[i]; }
            }
            __syncthreads(); }
        bf16x8 qf[4];
#pragma unroll
        for (int ks = 0; ks < 4; ++ks) qf[ks] = qfn[ks];
        if (st + 1 < nsteps) { attn_decode(p, st + 1, vb, nxt); attn_issue(nxt, tid, wid, q16, g, kr, vr, qfn); }
        if (G == 256 && st == 13 && wid >= 4) __builtin_amdgcn_s_sleep(48);
        const int first = cur.first, maxback = cur.maxback; const float c2 = cur.c2, sink2 = cur.sink2;
        const int qtok = cur.tq0 + (16 * wid + q16) * cur.d;
        bf16_t* qrow = cur.q + (size_t)qtok * cur.ldq;
        const int slotC = cur.par * 128, slotP = (cur.par ^ 1) * 128;
        f32x4 s[9];
#pragma unroll
        for (int t = 0; t < 9; ++t) { s[t] = (f32x4){0.f, 0.f, 0.f, 0.f};
            const int T = wid + t, rowb = ((T < 8) ? slotP : slotC) + (T & 7) * 16;
#pragma unroll
            for (int ks = 0; ks < 4; ++ks) { const bf16x8 a = *(const LAS bf16x8*)(lds + K_LDS + (rowb + q16) * K_PITCH + (32 * ks + 8 * g) * 2); s[t] = MFMA16(a, qf[ks], s[t]); } }
        float mx = -INFINITY;
#pragma unroll
        for (int t = 0; t < 9; ++t)
#pragma unroll
            for (int r = 0; r < 4; ++r) { const int rel = 128 + q16 - 16 * t - 4 * g - r, kk = 16 * (wid + t) + 4 * g + r;
                const bool valid = (rel >= 0) && (rel <= maxback) && !(first && kk < 128);
                const float v = valid ? (s[t][r] * c1 - c2 * (float)rel) : -INFINITY; s[t][r] = v; mx = fmaxf(mx, v); }
        mx = fmaxf(mx, __shfl_xor(mx, 16)); mx = fmaxf(mx, __shfl_xor(mx, 32));
        mx = fmaxf(mx, sink2);
        float sum = 0.f;
#pragma unroll
        for (int t = 0; t < 9; ++t)
#pragma unroll
            for (int r = 0; r < 4; ++r) { const float e = __builtin_amdgcn_exp2f(s[t][r] - mx); s[t][r] = e; sum += e; }
        sum += __shfl_xor(sum, 16); sum += __shfl_xor(sum, 32);
        sum += __builtin_amdgcn_exp2f(sink2 - mx);
        bf16x8 pf[5];
#pragma unroll
        for (int uu = 0; uu < 5; ++uu) { u32x4 w; w.x = cvt_pk_bf16(s[2 * uu][0], s[2 * uu][1]); w.y = cvt_pk_bf16(s[2 * uu][2], s[2 * uu][3]);
            if (uu < 4) { w.z = cvt_pk_bf16(s[2 * uu + 1][0], s[2 * uu + 1][1]); w.w = cvt_pk_bf16(s[2 * uu + 1][2], s[2 * uu + 1][3]); } else { w.z = 0u; w.w = 0u; }
            pf[uu] = __builtin_bit_cast(bf16x8, w); }
        const unsigned vcom = (unsigned)(size_t)(lds + V_LDS) + (unsigned)((4 * g + (q16 >> 2)) * V_PITCH + (q16 & 3) * 8);
        unsigned vbase[9];
#pragma unroll
        for (int t = 0; t < 9; ++t) { const int T = wid + t; vbase[t] = vcom + (unsigned)((((T < 8) ? slotP : slotC) + (T & 7) * 16) * V_PITCH); }
        const float inv = 1.0f / sum;
        s16x4 lo[2][5], hi[2][4];
#pragma unroll
        for (int uu = 0; uu < 5; ++uu) { TRRD(lo[0][uu], vbase[2 * uu], 0); if (uu < 4) TRRD(hi[0][uu], vbase[2 * uu + 1], 0); }
#pragma unroll
        for (int dt = 0; dt < 8; ++dt) {
            const int S = dt & 1;
            if (dt + 1 < 8) {
#pragma unroll
                for (int uu = 0; uu < 5; ++uu) { TRRD(lo[S ^ 1][uu], vbase[2 * uu], 32 * (dt + 1)); if (uu < 4) TRRD(hi[S ^ 1][uu], vbase[2 * uu + 1], 32 * (dt + 1)); }
                asm volatile("s_waitcnt lgkmcnt(9)" : "+v"(lo[S][0]), "+v"(lo[S][1]), "+v"(lo[S][2]), "+v"(lo[S][3]), "+v"(lo[S][4]), "+v"(hi[S][0]), "+v"(hi[S][1]), "+v"(hi[S][2]), "+v"(hi[S][3]) :: "memory");
            } else {
                asm volatile("s_waitcnt lgkmcnt(0)" : "+v"(lo[S][0]), "+v"(lo[S][1]), "+v"(lo[S][2]), "+v"(lo[S][3]), "+v"(lo[S][4]), "+v"(hi[S][0]), "+v"(hi[S][1]), "+v"(hi[S][2]), "+v"(hi[S][3]) :: "memory");
            }
            f32x4 o = (f32x4){0.f, 0.f, 0.f, 0.f};
#pragma unroll
            for (int uu = 0; uu < 5; ++uu) { const bf16x8 vf = (uu < 4) ? __builtin_shufflevector(lo[S][uu], hi[S][uu], 0, 1, 2, 3, 4, 5, 6, 7) : __builtin_shufflevector(lo[S][4], lo[S][4], 0, 1, 2, 3, 4, 5, 6, 7);
                o = MFMA16(vf, pf[uu], o); }
            u32x2 w; w.x = cvt_pk_bf16(o[0] * inv, o[1] * inv); w.y = cvt_pk_bf16(o[2] * inv, o[3] * inv);
            *(u32x2*)(qrow + 16 * dt + 4 * g) = w;
        }
        if (cur.lse && g == 0) cur.lse[(size_t)qtok * 8] = (mx + __builtin_amdgcn_logf(sum)) * LN2;
        cur = nxt;
    }
    __syncthreads();
}
__device__ __forceinline__ void combine_phase(const Params& p) {
    const bf16_t* QA = (const bf16_t*)(p.ws + WS_QA); const float* LSE = (const float*)(p.ws + WS_LSE); bf16_t* OA = (bf16_t*)((unsigned char*)p.out + DO_OA);
    const int nthr = gridDim.x * 512;
    int tid = threadIdx.x; asm volatile("" : "+v"(tid));
#pragma unroll 4
    for (int idx = blockIdx.x * 512 + tid; idx < MT * 128; idx += nthr) {
        const int tok = idx >> 7, hc = idx & 127, h = hc >> 4, c = hc & 15;
        const float l0 = LSE[((size_t)0 * MT + tok) * 8 + h], l1 = LSE[((size_t)1 * MT + tok) * 8 + h], l2 = LSE[((size_t)2 * MT + tok) * 8 + h];
        const float mx = fmaxf(l0, fmaxf(l1, l2)); float w0 = __expf(l0 - mx), w1 = __expf(l1 - mx), w2 = __expf(l2 - mx); const float inv = 1.0f / (w0 + w1 + w2); w0 *= inv; w1 *= inv; w2 *= inv;
        const bf16_t* base = QA + (size_t)tok * 3072 + h * 128 + 8 * c;
        const u32x4 a = __builtin_nontemporal_load((const u32x4*)(base)), b = __builtin_nontemporal_load((const u32x4*)(base + 1024)), cc = __builtin_nontemporal_load((const u32x4*)(base + 2048));
        u32x4 o;
#pragma unroll
        for (int j = 0; j < 4; ++j) { const float lo = w0 * bf_lo(a[j]) + w1 * bf_lo(b[j]) + w2 * bf_lo(cc[j]), hi = w0 * bf_hi(a[j]) + w1 * bf_hi(b[j]) + w2 * bf_hi(cc[j]); o[j] = cvt_pk_bf16(lo, hi); }
        *(u32x4*)(OA + (size_t)tok * 1024 + h * 128 + 8 * c) = o;
    }
}

__device__ __forceinline__ void grid_bar(unsigned* ctr, unsigned target) {
    asm volatile("s_waitcnt vmcnt(0)" ::: "memory");
    __syncthreads();
    if (threadIdx.x == 0) {
        __builtin_amdgcn_fence(__ATOMIC_RELEASE, "agent");
        asm volatile("s_waitcnt vmcnt(0)" ::: "memory");
        __hip_atomic_fetch_add(ctr, 1u, __ATOMIC_RELAXED, __HIP_MEMORY_SCOPE_AGENT);
        while (__hip_atomic_load(ctr, __ATOMIC_RELAXED, __HIP_MEMORY_SCOPE_AGENT) < target) __builtin_amdgcn_s_sleep(2);
        __builtin_amdgcn_fence(__ATOMIC_ACQUIRE, "agent");
        asm volatile("s_waitcnt vmcnt(0)" ::: "memory");
    }
    __syncthreads();
}
__global__ void __launch_bounds__(512, 2) mega(Params p) {
    extern __shared__ __attribute__((aligned(16))) unsigned char lds[];
    cg::grid_group grid = cg::this_grid();
    PG8_LAS unsigned char* L = (PG8_LAS unsigned char*)lds;
    const int G = gridDim.x, c = blockIdx.x;
    unsigned* bar = (unsigned*)(p.ws + WS_BAR); unsigned* gbar = bar + 64 * (1 + (c & 7)); const bool grouped = (G % 8 == 0);
    unsigned char* ws = p.ws; unsigned char* ob = (unsigned char*)p.out;
    bf16_t* H = (bf16_t*)(ob + DO_H); bf16_t* WtIn = (bf16_t*)(ob + DO_WIN); bf16_t* OA = (bf16_t*)(ob + DO_OA);
    bf16_t* WtBa = (bf16_t*)(ws + WS_WBA); bf16_t* WtBb = (bf16_t*)(ws + WS_WBB); bf16_t* WtOut = (bf16_t*)(ws + WS_WOUT); bf16_t* WtF1 = (bf16_t*)(ws + WS_WFF1); bf16_t* WtF2 = (bf16_t*)(ws + WS_WFF2);
    bf16_t* MRG = (bf16_t*)(ws + WS_MRG); bf16_t* H2 = (bf16_t*)(ws + WS_H2); bf16_t* ACT = (bf16_t*)(ws + WS_ACT);
    transpose_convert(p.w_in, WtIn, DM, INC, nullptr, lds);
    rmsnorm_rows(p.x, p.norm1_g, H);
    grid.sync();
    { PG8_LAS float* gl = (PG8_LAS float*)(L + pg8::STAGE_BYTES + 8192); const int t = threadIdx.x;
      gl[t] = (t < 128) ? p.qna[t] : (t < 256) ? p.kna[t - 128] : (t < 384) ? p.qnb[t - 256] : p.knb[t - 384]; __syncthreads(); }
    { pg8::Gemm g{H, WtIn, MT, INC, DM}; pg8::StaticOrder S; S.init(MT, INC, G, c, 1);
      pg8::EpiProj E{(bf16_t*)(ws + WS_QA), (bf16_t*)(ws + WS_KA), (bf16_t*)(ws + WS_VA), (bf16_t*)(ws + WS_QB), (bf16_t*)(ws + WS_KB), (bf16_t*)(ws + WS_VB), (bf16_t*)(ws + WS_GA), (bf16_t*)(ws + WS_GB)};
      pg8::gemm_phase(L, g, S, E); }
    if (G == 256) { if (c >= 128) { transpose_convert_part(p.wba, WtBa, 1024, DM, lds, c - 128, 128); transpose_convert_part(p.wbb, WtBb, DM, DM, lds, c - 128, 128); } }
    else { transpose_convert(p.wba, WtBa, 1024, DM, nullptr, lds); transpose_convert(p.wbb, WtBb, DM, DM, nullptr, lds); }
    grid_bar(bar, 1u * (unsigned)G);
    attn_phase(p, lds);
    grid_bar(bar, 2u * (unsigned)G);
    combine_phase(p);
    transpose_convert(p.wout, WtOut, DM, DM, nullptr, lds);
    transpose_convert(p.wff1, WtF1, DM, DFF, p.norm2_g, lds);
    transpose_convert(p.wff2, WtF2, DFF, DM, nullptr, lds);
    grid_bar(bar, 3u * (unsigned)G);
    { pg8::Gemm g{OA, WtBa, MT, DM, 1024}; pg8::StaticOrder S; S.init(MT, DM, G, c);
      pg8::EpiGate E{(const bf16_t*)(ws + WS_GA), nullptr, MRG, DM}; pg8::gemm_phase(L, g, S, E); }
    { pg8::Gemm g{(const bf16_t*)(ws + WS_QB), WtBb, MT, DM, DM}; pg8::StaticOrder S; S.init(MT, DM, G, c);
      pg8::EpiGate E{(const bf16_t*)(ws + WS_GB), MRG, MRG, DM}; pg8::gemm_phase(L, g, S, E); }
    if (grouped) grid_bar(gbar, 1u * (unsigned)(G >> 3)); else grid_bar(bar, 4u * (unsigned)G);
    { pg8::Gemm g{MRG, WtOut, MT, DM, DM}; pg8::StaticOrder S; S.init(MT, DM, G, c);
      pg8::EpiResX1 E{p.x, H2, (float*)(ws + WS_SSQ), DM}; pg8::gemm_phase(L, g, S, E); }
    grid_bar(bar, (grouped ? 4u : 5u) * (unsigned)G);
    { pg8::Gemm g{H2, WtF1, MT, DFF, DM}; pg8::StaticOrder S; S.init(MT, DFF, G, c, 1);
      pg8::Unit u0; if (S.next(0, u0)) { PG8_LAS float* RS = (PG8_LAS float*)(L + pg8::STAGE_BYTES + 8192 + 2048); const int t = threadIdx.x;
          if (t < 256) { const float* sp = (const float*)(ws + WS_SSQ) + (size_t)(u0.pm * 256 + t) * 8; const f32x4 p0 = *(const f32x4*)sp, p1 = *(const f32x4*)(sp + 4);
              RS[t] = rsqrtf((((p0[0] + p0[1]) + (p0[2] + p0[3])) + ((p1[0] + p1[1]) + (p1[2] + p1[3]))) * (1.0f / 2048.0f) + 1e-6f); } }
      __syncthreads();
      pg8::EpiRelu2 E{ACT, ACT_LD}; pg8::gemm_phase(L, g, S, E); }
    if (grouped) grid_bar(gbar, 2u * (unsigned)(G >> 3)); else grid_bar(bar, 6u * (unsigned)G);
    { pg8::Gemm g{ACT, WtF2, MT, DM, DFF, ACT_LD}; pg8::StaticOrder S; S.init(MT, DM, G, c);
      pg8::EpiFinal E{H2, p.out, DM}; pg8::gemm_phase(L, g, S, E); }
}

extern "C" void kernel_launch(void* const* d_in, const int* in_sizes, int n_in, void* d_out, int out_size, void* d_ws, size_t ws_size, hipStream_t stream) {
    static int grid_blocks = 0;
    if (!grid_blocks) {
        if (n_in != 14 || out_size != MT * DM || ws_size < WS_NEED) { fprintf(stderr, "kernel_launch: unexpected shapes (n_in %d out %d ws %zu)\n", n_in, out_size, ws_size); grid_blocks = -1; return; }
        int dev = 0, cus = 0, per_cu = 0;
        (void)hipGetDevice(&dev); (void)hipDeviceGetAttribute(&cus, hipDeviceAttributeMultiprocessorCount, dev);
        if (hipFuncSetAttribute((const void*)mega, hipFuncAttributeMaxDynamicSharedMemorySize, LDS_BYTES) != hipSuccess) { fprintf(stderr, "kernel_launch: hipFuncSetAttribute failed\n"); grid_blocks = -1; return; }
        (void)hipOccupancyMaxActiveBlocksPerMultiprocessor(&per_cu, (const void*)mega, 512, LDS_BYTES);
        if (per_cu < 1) { fprintf(stderr, "kernel_launch: occupancy query says %d blocks/CU\n", per_cu); }
        (void)hipGetLastError();
        if (cus % 64 != 0) { fprintf(stderr, "kernel_launch: built for a CU count that is a multiple of 64 (MI355X: 256), got %d; nothing launched\n", cus); grid_blocks = -1; return; }
        grid_blocks = cus;
    }
    if (grid_blocks < 0) return;
    Params p{};
    p.x = (const float*)d_in[0]; p.norm1_g = (const float*)d_in[1]; p.w_in = (const float*)d_in[2]; p.qna = (const float*)d_in[3]; p.kna = (const float*)d_in[4];
    p.qnb = (const float*)d_in[5]; p.knb = (const float*)d_in[6]; p.sinks = (const float*)d_in[7]; p.wba = (const float*)d_in[8]; p.wbb = (const float*)d_in[9];
    p.wout = (const float*)d_in[10]; p.norm2_g = (const float*)d_in[11]; p.wff1 = (const float*)d_in[12]; p.wff2 = (const float*)d_in[13];
    p.out = (float*)d_out; p.ws = (unsigned char*)d_ws;
    if (hipMemsetAsync((unsigned char*)d_ws + WS_BAR, 0, 4096, stream) != hipSuccess) { fprintf(stderr, "kernel_launch: memset of the barrier word failed\n"); return; }
    void* args[] = {&p};
    hipError_t e = hipLaunchCooperativeKernel((const void*)mega, dim3(grid_blocks), dim3(512), args, LDS_BYTES, stream);
    if (e != hipSuccess) fprintf(stderr, "cooperative launch failed: %s (grid %d)\n", hipGetErrorString(e), grid_blocks);
}
```

```cpp
#include <hip/hip_runtime.h>
#include <hip/hip_cooperative_groups.h>
#include <cstdio>
namespace cg = cooperative_groups;

namespace pg8 {
#define PG8_LAS __attribute__((address_space(3)))
typedef unsigned short bf16_t;
typedef short bf16x8 __attribute__((ext_vector_type(8)));
typedef float f32x4 __attribute__((ext_vector_type(4)));
typedef unsigned u32x4 __attribute__((ext_vector_type(4)));
constexpr int BM = 256, BK = 64, HALF = 128, HTB = HALF * BK * 2  , STAGE_BYTES = 8 * HTB, NXCD = 8, WGM = 8;

__host__ __device__ __forceinline__ int lds_byte(int r, int c) { const int st = (r >> 4) * 2 + (c >> 5), rr = r & 15, cc = c & 31, ob = rr * 64 + cc * 2; return st * 1024 + (ob ^ (((ob >> 9) & 1) << 5)); }
__host__ __device__ __forceinline__ void stage_rc(int b, int& R, int& C) { const int st = b / 1024, sb = b % 1024, swz = sb ^ (((sb >> 9) & 1) << 5); R = (st >> 1) * 16 + swz / 64; C = (st & 1) * 32 + (swz % 64) / 2; }
__host__ __device__ __forceinline__ int perm32(int rho) { const int n = rho >> 4, i = rho & 15; return 8 * (i >> 2) + 4 * n + (i & 3); }

struct Unit { int pm, pn; };
struct Gemm { const bf16_t* A; const bf16_t* Bt; int M, N, K; int lda = 0; };

struct StaticOrder {
    int nM, nN, nwg, G, c, flip;
    __host__ __device__ void init(int M, int N, int G_, int c_, int flip_ = 0) { nM = M / BM; nN = N / BM; nwg = nM * nN; G = G_; c = c_; flip = flip_; }
    __host__ __device__ bool next(int i, Unit& u) const {
        const long L = (long)i * G + c; if (L >= nwg) return false;
        int wgid = (int)L; { const int q = nwg / NXCD, r = nwg % NXCD, xcd = wgid % NXCD, off = wgid / NXCD; wgid = (xcd < r ? xcd * (q + 1) : r * (q + 1) + (xcd - r) * q) + off; }
        const int nig = WGM * nN, gid = wgid / nig, fm = gid * WGM, gsz = (nM - fm) < WGM ? (nM - fm) : WGM;
        u.pm = fm + ((wgid % nig) % gsz); u.pn = (wgid % nig) / gsz; if (flip) u.pn = nN - 1 - u.pn; return true;
    }
    __device__ __forceinline__ void a_ready(const Unit&) const {}
    __device__ __forceinline__ void done(const Unit&) const {}
};
__device__ __forceinline__ unsigned cvt_pk_bf16(float lo, float hi) { unsigned r; asm("v_cvt_pk_bf16_f32 %0, %1, %2" : "=v"(r) : "v"(lo), "v"(hi)); return r; }
typedef float f32x2 __attribute__((ext_vector_type(2)));
typedef unsigned u32x2 __attribute__((ext_vector_type(2)));
__device__ __forceinline__ float bf_lo(unsigned w) { return __uint_as_float(w << 16); }
__device__ __forceinline__ float bf_hi(unsigned w) { return __uint_as_float(w & 0xffff0000u); }

struct EpiProj {
    static constexpr bool PERM = true, AFTER_DRAIN = false;
    bf16_t *QA, *KA, *VA, *QB, *KB, *VB, *GA, *GB;
    __device__ __forceinline__ void operator()(const f32x4 (&acc)[2][2][4][2], const Unit& u, int wr, int wc, int fr, int fq, PG8_LAS unsigned char* xl) const {
        const int pn = u.pn; int mode, ldc, colt; bf16_t* base; int gsel = 0;
        if (pn < 12)       { mode = 1; base = QA; ldc = 3072; colt = pn * 256; gsel = 0; }
        else if (pn < 24)  { mode = 1; base = KA; ldc = 3072; colt = (pn - 12) * 256; gsel = 1; }
        else if (pn < 36)  { mode = 0; base = VA; ldc = 3072; colt = (pn - 24) * 256; }
        else if (pn < 44)  { mode = 1; base = QB; ldc = 2048; colt = (pn - 36) * 256; gsel = 2; }
        else if (pn == 44) { mode = 1; base = KB; ldc = 256; colt = 0; gsel = 3; }
        else if (pn == 45) { mode = 0; base = VB; ldc = 256; colt = 0; }
        else if (pn < 54)  { mode = 2; base = GA; ldc = 2048; colt = (pn - 46) * 256; }
        else               { mode = 2; base = GB; ldc = 2048; colt = (pn - 54) * 256; }
        const int row0 = u.pm * BM + wr * 64 + fr, col0 = colt + wc * 32 + 8 * fq;
        if (mode == 1) {
            PG8_LAS float* T = (PG8_LAS float*)xl;
#pragma unroll
            for (int ai = 0; ai < 2; ++ai)
#pragma unroll
                for (int m = 0; m < 4; ++m)
#pragma unroll
                    for (int bj = 0; bj < 2; ++bj) {
                        const f32x4 a = acc[ai][bj][m][0], b = acc[ai][bj][m][1];
                        float s = (a[0] * a[0] + a[1] * a[1]) + (a[2] * a[2] + a[3] * a[3]) + (b[0] * b[0] + b[1] * b[1]) + (b[2] * b[2] + b[3] * b[3]);
                        s += __shfl_xor(s, 16); s += __shfl_xor(s, 32);
                        if (fq == 0) T[((ai * HALF + wr * 64 + m * 16 + fr) * 2 + bj) * 4 + wc] = s;
                    }
            asm volatile("s_waitcnt lgkmcnt(0)" ::: "memory"); __builtin_amdgcn_s_barrier(); asm volatile("" ::: "memory");
            const PG8_LAS float* gl = (const PG8_LAS float*)(xl + 8192) + gsel * 128 + wc * 32 + 8 * fq;
            const f32x4 g0 = *(const PG8_LAS f32x4*)gl, g1 = *(const PG8_LAS f32x4*)(gl + 4);
#pragma unroll
            for (int ai = 0; ai < 2; ++ai)
#pragma unroll
                for (int m = 0; m < 4; ++m) { bf16_t* rowp = base + (size_t)(row0 + ai * HALF + m * 16) * ldc + col0;
#pragma unroll
                    for (int bj = 0; bj < 2; ++bj) {
                        const f32x4 t = *(const PG8_LAS f32x4*)(T + ((ai * HALF + wr * 64 + m * 16 + fr) * 2 + bj) * 4);
                        const float rs = rsqrtf(((t[0] + t[1]) + (t[2] + t[3])) * (1.0f / 128.0f) + 1e-6f);
                        const f32x4 v0 = acc[ai][bj][m][0] * rs * g0, v1 = acc[ai][bj][m][1] * rs * g1;
                        u32x4 w; w.x = cvt_pk_bf16(v0[0], v0[1]); w.y = cvt_pk_bf16(v0[2], v0[3]); w.z = cvt_pk_bf16(v1[0], v1[1]); w.w = cvt_pk_bf16(v1[2], v1[3]);
                        *(u32x4*)(rowp + bj * HALF) = w; } }
        } else {
#pragma unroll
            for (int ai = 0; ai < 2; ++ai)
#pragma unroll
                for (int m = 0; m < 4; ++m) { bf16_t* rowp = base + (size_t)(row0 + ai * HALF + m * 16) * ldc + col0;
#pragma unroll
                    for (int bj = 0; bj < 2; ++bj) { f32x4 v0 = acc[ai][bj][m][0], v1 = acc[ai][bj][m][1];
                        if (mode == 2) {
#pragma unroll
                            for (int j = 0; j < 4; ++j) { v0[j] = __builtin_amdgcn_rcpf(1.0f + __expf(-v0[j])); v1[j] = __builtin_amdgcn_rcpf(1.0f + __expf(-v1[j])); } }
                        u32x4 w; w.x = cvt_pk_bf16(v0[0], v0[1]); w.y = cvt_pk_bf16(v0[2], v0[3]); w.z = cvt_pk_bf16(v1[0], v1[1]); w.w = cvt_pk_bf16(v1[2], v1[3]);
                        if (mode == 2) __builtin_nontemporal_store(w, (u32x4*)(rowp + bj * HALF)); else *(u32x4*)(rowp + bj * HALF) = w; } }
        }
    }
};
struct EpiGate {
    static constexpr bool PERM = true, AFTER_DRAIN = false;
    const bf16_t* G; const bf16_t* addend; bf16_t* out; int ldc;
    __device__ __forceinline__ void operator()(const f32x4 (&acc)[2][2][4][2], const Unit& u, int wr, int wc, int fr, int fq, PG8_LAS unsigned char*) const {
        const int row0 = u.pm * BM + wr * 64 + fr, col0 = u.pn * BM + wc * 32 + 8 * fq;
#pragma unroll
        for (int ai = 0; ai < 2; ++ai)
#pragma unroll
            for (int m = 0; m < 4; ++m) { const size_t roff = (size_t)(row0 + ai * HALF + m * 16) * ldc + col0;
#pragma unroll
                for (int bj = 0; bj < 2; ++bj) { const size_t off = roff + bj * HALF;
                    const u32x4 gw = __builtin_nontemporal_load((const u32x4*)(G + off));     f32x4 v0 = acc[ai][bj][m][0], v1 = acc[ai][bj][m][1];
                    v0[0] *= bf_lo(gw.x); v0[1] *= bf_hi(gw.x); v0[2] *= bf_lo(gw.y); v0[3] *= bf_hi(gw.y);
                    v1[0] *= bf_lo(gw.z); v1[1] *= bf_hi(gw.z); v1[2] *= bf_lo(gw.w); v1[3] *= bf_hi(gw.w);
                    if (addend) { const u32x4 aw = *(const u32x4*)(addend + off);
                        v0[0] += bf_lo(aw.x); v0[1] += bf_hi(aw.x); v0[2] += bf_lo(aw.y); v0[3] += bf_hi(aw.y);
                        v1[0] += bf_lo(aw.z); v1[1] += bf_hi(aw.z); v1[2] += bf_lo(aw.w); v1[3] += bf_hi(aw.w); }
                    u32x4 w; w.x = cvt_pk_bf16(v0[0], v0[1]); w.y = cvt_pk_bf16(v0[2], v0[3]); w.z = cvt_pk_bf16(v1[0], v1[1]); w.w = cvt_pk_bf16(v1[2], v1[3]);
                    *(u32x4*)(out + off) = w; } }
    }
};
struct EpiResF32 {
    static constexpr bool PERM = true, AFTER_DRAIN = false;
    const float* res; float* out; int ldc;
    __device__ __forceinline__ void operator()(const f32x4 (&acc)[2][2][4][2], const Unit& u, int wr, int wc, int fr, int fq, PG8_LAS unsigned char*) const {
        const int row0 = u.pm * BM + wr * 64 + fr, col0 = u.pn * BM + wc * 32 + 8 * fq;
#pragma unroll
        for (int ai = 0; ai < 2; ++ai)
#pragma unroll
            for (int m = 0; m < 4; ++m) { const size_t roff = (size_t)(row0 + ai * HALF + m * 16) * ldc + col0;
#pragma unroll
                for (int bj = 0; bj < 2; ++bj)
#pragma unroll
                    for (int n = 0; n < 2; ++n) { const size_t off = roff + bj * HALF + n * 4; const f32x4 r = *(const f32x4*)(res + off); *(f32x4*)(out + off) = r + acc[ai][bj][m][n]; } }
    }
};
struct EpiResX1 {
    static constexpr bool PERM = true, AFTER_DRAIN = false;
    const float* res; bf16_t* xb; float* ssqp; int ldc;
    __device__ __forceinline__ void operator()(const f32x4 (&acc)[2][2][4][2], const Unit& u, int wr, int wc, int fr, int fq, PG8_LAS unsigned char* xl) const {
        const int row0 = u.pm * BM + wr * 64 + fr, col0 = u.pn * BM + wc * 32 + 8 * fq;
        PG8_LAS float* T = (PG8_LAS float*)xl;
#pragma unroll
        for (int ai = 0; ai < 2; ++ai)
#pragma unroll
            for (int m = 0; m < 4; ++m) { const size_t roff = (size_t)(row0 + ai * HALF + m * 16) * ldc + col0; float s = 0.f;
#pragma unroll
                for (int bj = 0; bj < 2; ++bj) { const size_t off = roff + bj * HALF;
                    const f32x4 v0 = __builtin_nontemporal_load((const f32x4*)(res + off)) + acc[ai][bj][m][0], v1 = __builtin_nontemporal_load((const f32x4*)(res + off + 4)) + acc[ai][bj][m][1];
                    u32x4 w; w.x = cvt_pk_bf16(v0[0], v0[1]); w.y = cvt_pk_bf16(v0[2], v0[3]); w.z = cvt_pk_bf16(v1[0], v1[1]); w.w = cvt_pk_bf16(v1[2], v1[3]);
                    *(u32x4*)(xb + off) = w;
                    s += (v0[0] * v0[0] + v0[1] * v0[1]) + (v0[2] * v0[2] + v0[3] * v0[3]) + (v1[0] * v1[0] + v1[1] * v1[1]) + (v1[2] * v1[2] + v1[3] * v1[3]); }
                s += __shfl_xor(s, 16); s += __shfl_xor(s, 32);
                if (fq == 0) T[(ai * HALF + wr * 64 + m * 16 + fr) * 4 + wc] = s; }
        asm volatile("s_waitcnt lgkmcnt(0)" ::: "memory"); __builtin_amdgcn_s_barrier(); asm volatile("" ::: "memory");
        if (wc == 0 && fq == 0) {
#pragma unroll
            for (int ai = 0; ai < 2; ++ai)
#pragma unroll
                for (int m = 0; m < 4; ++m) { const int r = ai * HALF + wr * 64 + m * 16 + fr; const f32x4 t = *(const PG8_LAS f32x4*)(T + r * 4);
                    ssqp[(size_t)(u.pm * BM + r) * 8 + u.pn] = (t[0] + t[1]) + (t[2] + t[3]); } }
    }
};
struct EpiFinal {
    static constexpr bool PERM = true, AFTER_DRAIN = false;
    const bf16_t* res; float* out; int ldc;
    __device__ __forceinline__ void operator()(const f32x4 (&acc)[2][2][4][2], const Unit& u, int wr, int wc, int fr, int fq, PG8_LAS unsigned char*) const {
        const int row0 = u.pm * BM + wr * 64 + fr, col0 = u.pn * BM + wc * 32 + 8 * fq;
#pragma unroll
        for (int ai = 0; ai < 2; ++ai)
#pragma unroll
            for (int m = 0; m < 4; ++m) { const size_t roff = (size_t)(row0 + ai * HALF + m * 16) * ldc + col0;
#pragma unroll
                for (int bj = 0; bj < 2; ++bj) { const size_t off = roff + bj * HALF; const u32x4 rw = __builtin_nontemporal_load((const u32x4*)(res + off));
                    f32x4 v0 = acc[ai][bj][m][0], v1 = acc[ai][bj][m][1];
                    v0[0] += bf_lo(rw.x); v0[1] += bf_hi(rw.x); v0[2] += bf_lo(rw.y); v0[3] += bf_hi(rw.y);
                    v1[0] += bf_lo(rw.z); v1[1] += bf_hi(rw.z); v1[2] += bf_lo(rw.w); v1[3] += bf_hi(rw.w);
                    __builtin_nontemporal_store(v0, (f32x4*)(out + off)); __builtin_nontemporal_store(v1, (f32x4*)(out + off + 4)); } }
    }
};
struct EpiRelu2 {
    static constexpr bool PERM = true, AFTER_DRAIN = false;
    bf16_t* out; int ldc;
    __device__ __forceinline__ void operator()(const f32x4 (&acc)[2][2][4][2], const Unit& u, int wr, int wc, int fr, int fq, PG8_LAS unsigned char* xl) const {
        const int row0 = u.pm * BM + wr * 64 + fr, col0 = u.pn * BM + wc * 32 + 8 * fq;
        const PG8_LAS float* RS = (const PG8_LAS float*)(xl + 8192 + 2048);
#pragma unroll
        for (int ai = 0; ai < 2; ++ai)
#pragma unroll
            for (int m = 0; m < 4; ++m) { const int rl = wr * 64 + fr + ai * HALF + m * 16; bf16_t* rowp = out + (size_t)(u.pm * BM + rl) * ldc + col0;
                const float rs = RS[rl];
#pragma unroll
                for (int bj = 0; bj < 2; ++bj) { f32x4 v0 = acc[ai][bj][m][0], v1 = acc[ai][bj][m][1];
#pragma unroll
                    for (int j = 0; j < 4; ++j) { const float a = fmaxf(v0[j] * rs, 0.f), b = fmaxf(v1[j] * rs, 0.f); v0[j] = a * a; v1[j] = b * b; }
                    u32x4 w; w.x = cvt_pk_bf16(v0[0], v0[1]); w.y = cvt_pk_bf16(v0[2], v0[3]); w.z = cvt_pk_bf16(v1[0], v1[1]); w.w = cvt_pk_bf16(v1[2], v1[3]);
                    *(u32x4*)(rowp + bj * HALF) = w; } }
    }
};

template <class Epi, class Sched>
__device__ __forceinline__ void gemm_phase(PG8_LAS unsigned char* lds, const Gemm g, const Sched& S, const Epi& E) {
    int tid = threadIdx.x; asm volatile("" : "+v"(tid));
    const int wid = __builtin_amdgcn_readfirstlane(tid >> 6), lane = tid & 63, wr = wid >> 2, wc = wid & 3, fr = lane & 15, fq = lane >> 4;
    const int K = g.K, nt = K / BK;
    const int lda = g.lda ? g.lda : K;
    unsigned voffA[2], voffB[2];
#pragma unroll
    for (int i = 0; i < 2; ++i) { int R, C; stage_rc(tid * 16 + i * 8192, R, C); const int Rb = Epi::PERM ? ((R & ~31) + perm32(R & 31)) : R;
        voffA[i] = (unsigned)(R * lda + C) * 2u; voffB[i] = (unsigned)(Rb * K + C) * 2u; }
    const size_t kstep = (size_t)(BK * 2);
    const size_t hstepA = (size_t)HALF * lda * 2, hstepB = (size_t)HALF * K * 2;
    const size_t tstepA = 2 * hstepA, tstepB = 2 * hstepB;
    const unsigned ldsw = (unsigned)wid * 1024u;
    const int aoff = lds_byte(wr * 64 + fr, fq * 8), boff = lds_byte(wc * 32 + fr, fq * 8);
#define PG8_SA(b, h) (((b) * 2 + (h)) * HTB)
#define PG8_SB(b, h) ((4 + (b) * 2 + (h)) * HTB)
#define PG8_STAGE(bufoff, gbase, voff) do { _Pragma("unroll") for (int _i = 0; _i < 2; ++_i) \
        __builtin_amdgcn_global_load_lds((const unsigned*)((const char*)(gbase) + (voff)[_i]), (PG8_LAS unsigned*)(lds + (bufoff) + ldsw + _i * 8192), 16, 0, 0); } while (0)
#define PG8_LDA(dst, b, h) do { _Pragma("unroll") for (int m = 0; m < 4; ++m) _Pragma("unroll") for (int k = 0; k < 2; ++k) dst[m][k] = *(const PG8_LAS bf16x8*)(lds + PG8_SA(b, h) + aoff + m * 2048 + k * 1024); } while (0)
#define PG8_LDB(dst, b, h) do { _Pragma("unroll") for (int n = 0; n < 2; ++n) _Pragma("unroll") for (int k = 0; k < 2; ++k) dst[n][k] = *(const PG8_LAS bf16x8*)(lds + PG8_SB(b, h) + boff + n * 2048 + k * 1024); } while (0)
#define PG8_MMA(ai, bj, At, Bt) do { __builtin_amdgcn_s_setprio(1); _Pragma("unroll") for (int m = 0; m < 4; ++m) _Pragma("unroll") for (int n = 0; n < 2; ++n) _Pragma("unroll") for (int k = 0; k < 2; ++k) \
        acc[ai][bj][m][n] = __builtin_amdgcn_mfma_f32_16x16x32_bf16(Bt[n][k], At[m][k], acc[ai][bj][m][n], 0, 0, 0); __builtin_amdgcn_s_setprio(0); } while (0)
#define PG8_WAIT_V(n) asm volatile("s_waitcnt vmcnt(" #n ")" ::: "memory")
#define PG8_WAIT_L(n) asm volatile("s_waitcnt lgkmcnt(" #n ")" ::: "memory")
#define PG8_BAR __builtin_amdgcn_s_barrier()
#define PG8_SCHED __builtin_amdgcn_sched_barrier(0)
    Unit cur, nxt; int ui = 0;
    if (!S.next(0, cur)) return;
    f32x4 acc[2][2][4][2];
#pragma unroll
    for (int a = 0; a < 2; ++a)
#pragma unroll
        for (int b = 0; b < 2; ++b)
#pragma unroll
            for (int m = 0; m < 4; ++m)
#pragma unroll
                for (int n = 0; n < 2; ++n) acc[a][b][m][n] = (f32x4){0.f, 0.f, 0.f, 0.f};
    bf16x8 At[4][2], B0[2][2], B1[2][2];
    const char* cA = (const char*)g.A + (size_t)cur.pm * tstepA; const char* cB = (const char*)g.Bt + (size_t)cur.pn * tstepB;
    S.a_ready(cur);
    PG8_STAGE(PG8_SB(0, 0), cB, voffB); PG8_STAGE(PG8_SA(0, 0), cA, voffA); PG8_STAGE(PG8_SB(0, 1), cB + hstepB, voffB); PG8_STAGE(PG8_SA(0, 1), cA + hstepA, voffA);
    if (wr == 1) PG8_BAR;
    PG8_WAIT_V(4); PG8_BAR;
    PG8_STAGE(PG8_SB(1, 0), cB + kstep, voffB); PG8_STAGE(PG8_SA(1, 0), cA + kstep, voffA); PG8_STAGE(PG8_SB(1, 1), cB + hstepB + kstep, voffB);
    PG8_WAIT_V(6); PG8_BAR;
    for (;;) {
        const bool has_next = S.next(ui + 1, nxt);
        const char* nA = has_next ? (const char*)g.A + (size_t)nxt.pm * tstepA : cA; const char* nB = has_next ? (const char*)g.Bt + (size_t)nxt.pn * tstepB : cB;
        for (int t = 0; t < nt; t += 2) {
            const bool last = (t == nt - 2);
            const char* a1 = cA + (size_t)(t + 1) * kstep;
            const char* a2 = last ? nA : cA + (size_t)(t + 2) * kstep; const char* b2 = last ? nB : cB + (size_t)(t + 2) * kstep;
            const char* a3 = a2 + kstep; const char* b3 = b2 + kstep;
            if (last && has_next) S.a_ready(nxt);
            PG8_LDB(B0, 0, 0); PG8_SCHED; PG8_LDA(At, 0, 0); PG8_STAGE(PG8_SA(1, 1), a1 + hstepA, voffA);
            PG8_WAIT_L(8); PG8_BAR; PG8_WAIT_L(0); PG8_MMA(0, 0, At, B0); PG8_BAR; PG8_SCHED;
            PG8_LDB(B1, 0, 1); PG8_STAGE(PG8_SB(0, 0), b2, voffB);
            PG8_BAR; PG8_WAIT_L(0); PG8_MMA(0, 1, At, B1); PG8_BAR;
            PG8_LDA(At, 0, 1); PG8_STAGE(PG8_SA(0, 0), a2, voffA);
            PG8_BAR; PG8_WAIT_L(0); PG8_MMA(1, 0, At, B0); PG8_BAR; PG8_SCHED;
            PG8_STAGE(PG8_SB(0, 1), b2 + hstepB, voffB);
            PG8_WAIT_V(6); PG8_BAR; PG8_MMA(1, 1, At, B1); PG8_BAR;
            PG8_LDB(B0, 1, 0); PG8_SCHED; PG8_LDA(At, 1, 0); PG8_STAGE(PG8_SA(0, 1), a2 + hstepA, voffA);
            PG8_WAIT_L(8); PG8_BAR; PG8_WAIT_L(0); PG8_MMA(0, 0, At, B0); PG8_BAR; PG8_SCHED;
            PG8_LDB(B1, 1, 1); PG8_STAGE(PG8_SB(1, 0), b3, voffB);
            PG8_BAR; PG8_WAIT_L(0); PG8_MMA(0, 1, At, B1); PG8_BAR;
            PG8_LDA(At, 1, 1); PG8_STAGE(PG8_SA(1, 0), a3, voffA);
            PG8_BAR; PG8_WAIT_L(0); PG8_MMA(1, 0, At, B0); PG8_BAR; PG8_SCHED;
            PG8_STAGE(PG8_SB(1, 1), b3 + hstepB, voffB);
            PG8_WAIT_V(6); PG8_BAR; PG8_MMA(1, 1, At, B1); PG8_BAR;
        }
        E(acc, cur, wr, wc, fr, fq, lds + STAGE_BYTES); S.done(cur);
        if (!has_next) break;
#pragma unroll
        for (int a = 0; a < 2; ++a)
#pragma unroll
            for (int b = 0; b < 2; ++b)
#pragma unroll
                for (int m = 0; m < 4; ++m)
#pragma unroll
                    for (int n = 0; n < 2; ++n) acc[a][b][m][n] = (f32x4){0.f, 0.f, 0.f, 0.f};
        cur = nxt; cA = nA; cB = nB; ++ui;
    }
    PG8_WAIT_V(0);
    if (wr == 0) PG8_BAR;
    PG8_BAR;
#undef PG8_SA
#undef PG8_SB
#undef PG8_STAGE
#undef PG8_LDA
#undef PG8_LDB
#undef PG8_MMA
#undef PG8_WAIT_V
#undef PG8_WAIT_L
#undef PG8_BAR
#undef PG8_SCHED
}
}

using pg8::bf16_t; using pg8::bf16x8; using pg8::f32x4; using pg8::u32x4; using pg8::u32x2; using pg8::cvt_pk_bf16; using pg8::bf_lo; using pg8::bf_hi;
#define LAS __attribute__((address_space(3)))
typedef short s16x4 __attribute__((ext_vector_type(4)));
constexpr int MT = 16384, TSEQ = 8192, DM = 2048, INC = 15872, DFF = 8192, ACT_LD = DFF + 64;
constexpr size_t MiB = (size_t)1 << 20;
constexpr size_t WS_KA = 0, WS_QA = 96 * MiB, WS_VA = 192 * MiB, WS_QB = 288 * MiB, WS_KB = 352 * MiB, WS_VB = 360 * MiB, WS_GA = 368 * MiB, WS_GB = 432 * MiB,
                 WS_WBA = 496 * MiB, WS_WBB = 500 * MiB, WS_LSE = 508 * MiB, WS_SSQ = 510 * MiB, WS_BAR = 511 * MiB, WS_NEED = 512 * MiB;
constexpr size_t WS_WOUT = 0, WS_WFF1 = 8 * MiB, WS_WFF2 = 40 * MiB;
constexpr size_t WS_MRG = WS_VA, WS_H2 = WS_QA, WS_ACT = 192 * MiB;
constexpr size_t DO_H = 0, DO_WIN = 64 * MiB, DO_OA = 0;
constexpr int LDS_BYTES = 144 * 1024;
constexpr int K_PITCH = 272, V_PITCH = 288, K_LDS = 0, V_LDS = 256 * K_PITCH;

struct Params {
    const float *x, *norm1_g, *w_in, *qna, *kna, *qnb, *knb, *sinks, *wba, *wbb, *wout, *norm2_g, *wff1, *wff2;
    float* out; unsigned char* ws;
};

#define TRRD(dst, base, off) asm volatile("ds_read_b64_tr_b16 %0, %1 offset:%2" : "=&v"(dst) : "v"(base), "i"(off) : "memory")
__device__ __forceinline__ void transpose_convert_impl(const float* __restrict__ W, bf16_t* __restrict__ Wt, int K, int N, const float* __restrict__ kgain, unsigned char* lds_g, const int t_first, const int t_stride) {
    LAS unsigned char* lds = (LAS unsigned char*)lds_g;
    int tid = threadIdx.x; asm volatile("" : "+v"(tid));
    const int lane = tid & 63, w = tid >> 6, c = tid & 31, r = tid >> 5;
    const int tiles_n = N >> 7, nt = tiles_n * (K >> 7);
    const int gg = lane >> 4, i16 = lane & 15, q = i16 >> 2, pp = i16 & 3;
    const int nb = 2 * (w & 3) + (gg & 1), kb0 = (gg >> 1) + 8 * (w >> 2);
    const unsigned rd = (unsigned)(size_t)lds + (unsigned)((8 * kb0 + q) * 320 + (16 * nb + 4 * pp) * 2);
    f32x4 v[8];
    int t = t_first;
    if (t < nt) { const int tk = t / tiles_n, tn = t - tk * tiles_n; const float* src = W + (size_t)((tk << 7) + r) * N + (tn << 7) + 4 * c;
#pragma unroll
        for (int i = 0; i < 8; ++i) v[i] = __builtin_nontemporal_load((const f32x4*)(src + (size_t)(16 * i) * N));     }
    for (; t < nt; t += t_stride) {
        const int tk = t / tiles_n, tn = t - tk * tiles_n, k0 = tk << 7, n0 = tn << 7;
#pragma unroll
        for (int i = 0; i < 8; ++i) { const float g = kgain ? kgain[k0 + r + 16 * i] : 1.0f; u32x2 wv; wv.x = cvt_pk_bf16(v[i][0] * g, v[i][1] * g); wv.y = cvt_pk_bf16(v[i][2] * g, v[i][3] * g);
            *(LAS u32x2*)(lds + (r + 16 * i) * 320 + 8 * c) = wv; }
        const int t2 = t + t_stride;
        if (t2 < nt) { const int tk2 = t2 / tiles_n, tn2 = t2 - tk2 * tiles_n; const float* src = W + (size_t)((tk2 << 7) + r) * N + (tn2 << 7) + 4 * c;
#pragma unroll
            for (int i = 0; i < 8; ++i) v[i] = __builtin_nontemporal_load((const f32x4*)(src + (size_t)(16 * i) * N));     }
        __syncthreads();
        s16x4 lo[4], hi[4];
#pragma unroll
        for (int jj = 0; jj < 4; ++jj) { TRRD(lo[jj], rd, (16 * jj) * 320); TRRD(hi[jj], rd, (16 * jj + 4) * 320); }
        asm volatile("s_waitcnt lgkmcnt(0)" : "+v"(lo[0]), "+v"(lo[1]), "+v"(lo[2]), "+v"(lo[3]), "+v"(hi[0]), "+v"(hi[1]), "+v"(hi[2]), "+v"(hi[3]) :: "memory");
        bf16_t* dst = Wt + (size_t)(n0 + 16 * nb + i16) * K + k0 + 8 * kb0;
#pragma unroll
        for (int jj = 0; jj < 4; ++jj) *(bf16x8*)(dst + 16 * jj) = __builtin_shufflevector(lo[jj], hi[jj], 0, 1, 2, 3, 4, 5, 6, 7);
        __syncthreads();
    }
}
__device__ __forceinline__ void transpose_convert(const float* __restrict__ W, bf16_t* __restrict__ Wt, int K, int N, const float* __restrict__ kgain, unsigned char* lds_g) { transpose_convert_impl(W, Wt, K, N, kgain, lds_g, (int)blockIdx.x, (int)gridDim.x); }
__device__ __forceinline__ void transpose_convert_part(const float* __restrict__ W, bf16_t* __restrict__ Wt, int K, int N, unsigned char* lds_g, int first, int stride) { transpose_convert_impl(W, Wt, K, N, nullptr, lds_g, first, stride); }
__device__ __forceinline__ void rmsnorm_rows(const float* X, const float* __restrict__ g, bf16_t* H) {
    int tid = threadIdx.x; asm volatile("" : "+v"(tid));
    const int lane = tid & 63, wv = blockIdx.x * 8 + (tid >> 6), nw = gridDim.x * 8;
    f32x4 v[8], vn[8];
    if (wv < MT) { const f32x4* xr = (const f32x4*)(X + (size_t)wv * DM);
#pragma unroll
        for (int i = 0; i < 8; ++i) vn[i] = __builtin_nontemporal_load(xr + lane + 64 * i); }
    for (int row = wv; row < MT; row += nw) {
        float s = 0.f;
#pragma unroll
        for (int i = 0; i < 8; ++i) { v[i] = vn[i]; s += (v[i][0] * v[i][0] + v[i][1] * v[i][1]) + (v[i][2] * v[i][2] + v[i][3] * v[i][3]); }
        if (row + nw < MT) { const f32x4* xr = (const f32x4*)(X + (size_t)(row + nw) * DM);
#pragma unroll
            for (int i = 0; i < 8; ++i) vn[i] = __builtin_nontemporal_load(xr + lane + 64 * i); }
#pragma unroll
        for (int o = 32; o >= 1; o >>= 1) s += __shfl_xor(s, o);
        const float rs = rsqrtf(s * (1.0f / DM) + 1e-6f);
#pragma unroll
        for (int i = 0; i < 8; ++i) { const f32x4 gg = ((const f32x4*)g)[lane + 64 * i]; const f32x4 y = v[i] * rs * gg;
            u32x2 w; w.x = cvt_pk_bf16(y[0], y[1]); w.y = cvt_pk_bf16(y[2], y[3]); *(u32x2*)(H + (size_t)row * DM + 4 * (lane + 64 * i)) = w; }
    }
}
#define MFMA16(a, b, c) __builtin_amdgcn_mfma_f32_16x16x32_bf16((a), (b), (c), 0, 0, 0)
struct AUnit { bf16_t* q; const bf16_t* k; const bf16_t* v; float* lse; int ldq, ldk, d, tq0, first, maxback, newkv, reuse, par; float c2, sink2; };
__device__ __forceinline__ void attn_decode(const Params& p, int step, int vb, AUnit& a) {
    const float LOG2E = 1.4426950408889634f;
    const int G = gridDim.x; const bool packed = (G == 256);
    const int u = packed ? (step < 12 ? 12 * vb + step : 3072 + (step - 12) * 256 + vb) : vb + G * step;
    bf16_t* QA = (bf16_t*)(p.ws + WS_QA); const bf16_t* KA = (const bf16_t*)(p.ws + WS_KA); const bf16_t* VA = (const bf16_t*)(p.ws + WS_VA);
    bf16_t* QB = (bf16_t*)(p.ws + WS_QB); const bf16_t* KB = (const bf16_t*)(p.ws + WS_KB); const bf16_t* VB = (const bf16_t*)(p.ws + WS_VB);
    int hidx;
    a.par = step & 1;
    if (u < 3072) { const int b = u / 1536, rem = u - b * 1536, grp = rem >> 9, h = (rem >> 6) & 7, jr = rem & 63;
        a.d = 1 << (2 * grp); const int nb = 64 >> (2 * grp), r = jr / nb, jb = jr - r * nb;
        a.tq0 = jb * 128 * a.d + r; a.first = (jb == 0);
        const size_t hoff = (size_t)b * TSEQ * 3072 + (size_t)(grp * 8 + h) * 128;
        a.q = QA + hoff; a.k = KA + hoff; a.v = VA + hoff; a.ldq = 3072; a.ldk = 3072; hidx = 16 + grp * 8 + h; a.maxback = 128; a.sink2 = -INFINITY;
        a.lse = (float*)(p.ws + WS_LSE) + ((size_t)grp * MT + (size_t)b * TSEQ) * 8 + h; a.newkv = 1;
        a.reuse = (packed && step > 0 && jb != 0);
    } else { const int u2 = u - 3072, qh = u2 >> 8, sup = u2 & 255, j = sup & 63, kvh = (sup >> 6) & 1, b = sup >> 7;
        a.d = 1; a.tq0 = j * 128; a.first = (j == 0);
        a.q = QB + (size_t)b * TSEQ * 2048 + (size_t)(kvh * 8 + qh) * 128; a.ldq = 2048;
        a.k = KB + (size_t)b * TSEQ * 256 + (size_t)kvh * 128; a.v = VB + (size_t)b * TSEQ * 256 + (size_t)kvh * 128; a.ldk = 256;
        hidx = kvh * 8 + qh; a.maxback = 127; a.sink2 = p.sinks[hidx] * LOG2E; a.lse = nullptr; a.newkv = (qh == 0) || !packed; a.reuse = 0;
        if (packed) a.par = 0; }
    a.c2 = exp2f(-0.2f * (float)(hidx + 1)) * (float)a.d * LOG2E;
}
__device__ __forceinline__ void attn_issue(const AUnit& a, int tid, int wid, int q16, int g, u32x4 (&kr)[4], u32x4 (&vr)[4], bf16x8 (&qf)[4]) {
    const int ch = tid & 15, r0 = tid >> 4;
    if (a.newkv) {
#pragma unroll
        for (int i = 0; i < 4; ++i) { const size_t off = (size_t)(a.tq0 + (r0 + 32 * i) * a.d) * a.ldk + 8 * ch;
            kr[i] = *(const u32x4*)(a.k + off); vr[i] = *(const u32x4*)(a.v + off); } }
    const bf16_t* qrow = a.q + (size_t)(a.tq0 + (16 * wid + q16) * a.d) * a.ldq;
#pragma unroll
    for (int ks = 0; ks < 4; ++ks) qf[ks] = *(const bf16x8*)(qrow + 32 * ks + 8 * g);
}
__device__ __forceinline__ void attn_phase(const Params& p, unsigned char* lds_g) {
    LAS unsigned char* lds = (LAS unsigned char*)lds_g;
    int tid = threadIdx.x; asm volatile("" : "+v"(tid));
    const int lane = tid & 63, wid = __builtin_amdgcn_readfirstlane(tid >> 6), q16 = lane & 15, g = lane >> 4;
    const int G = gridDim.x, vb = (G % 8 == 0) ? ((int)(blockIdx.x & 7) * (G >> 3) + (int)(blockIdx.x >> 3)) : (int)blockIdx.x;
    const int nsteps = (G == 256) ? 20 : (5120 - vb + G - 1) / G;
    const float LN2 = 0.6931471805599453f;
    const float c1 = 0.08838834764831845f * 1.4426950408889634f;
    const int ch = tid & 15, r0 = tid >> 4;
    AUnit cur, nxt; u32x4 kr[4], vr[4]; bf16x8 qfn[4];
    if (nsteps > 0) { attn_decode(p, 0, vb, cur); attn_issue(cur, tid, wid, q16, g, kr, vr, qfn); }
    for (int st = 0; st < nsteps; ++st) {
        if (cur.newkv) {
            const int slotC = cur.par * 128, slotP = (cur.par ^ 1) * 128;
            __syncthreads();
#pragma unroll
            for (int i = 0; i < 4; ++i) { const int row = slotC + r0 + 32 * i;
                *(LAS u32x4*)(lds + K_LDS + row * K_PITCH + ch * 16) = kr[i]; *(LAS u32x4*)(lds + V_LDS + row * V_PITCH + ch * 16) = vr[i]; }
            if (cur.first) {
                const u32x4 z = {0u, 0u, 0u, 0u};
#pragma unroll
                for (int i = 0; i < 4; ++i) *(LAS u32x4*)(lds + V_LDS + (slotP + r0 + 32 * i) * V_PITCH + ch * 16) = z;
            } else if (!cur.reuse) {
                u32x4 kp[4], vp[4];
#pragma unroll
                for (int i = 0; i < 4; ++i) { const size_t off = (size_t)((long)cur.tq0 + (long)(r0 + 32 * i - 128) * cur.d) * cur.ldk + 8 * ch;
                    kp[i] = *(const u32x4*)(cur.k + off); vp[i] = *(const u32x4*)(cur.v + off); }
#pragma unroll
                for (int i = 0; i < 4; ++i) { const int row = slotP + r0 + 32 * i;
                    *(LAS u32x4*)(lds + K_LDS + row * K_PITCH + ch * 16) = kp[i]; *(LAS u32x4*)(lds + V_LDS + row * V_PITCH + ch * 16) = vp[i]; }
            }
            __syncthreads(); }
        bf16x8 qf[4];
#pragma unroll
        for (int ks = 0; ks < 4; ++ks) qf[ks] = qfn[ks];
        if (st + 1 < nsteps) { attn_decode(p, st + 1, vb, nxt); attn_issue(nxt, tid, wid, q16, g, kr, vr, qfn); }
        const int first = cur.first, maxback = cur.maxback; const float c2 = cur.c2, sink2 = cur.sink2;
        const int qtok = cur.tq0 + (16 * wid + q16) * cur.d;
        bf16_t* qrow = cur.q + (size_t)qtok * cur.ldq;
        const int slotC = cur.par * 128, slotP = (cur.par ^ 1) * 128;
        f32x4 s[9];
#pragma unroll
        for (int t = 0; t < 9; ++t) { s[t] = (f32x4){0.f, 0.f, 0.f, 0.f};
            const int T = wid + t, rowb = ((T < 8) ? slotP : slotC) + (T & 7) * 16;
#pragma unroll
            for (int ks = 0; ks < 4; ++ks) { const bf16x8 a = *(const LAS bf16x8*)(lds + K_LDS + (rowb + q16) * K_PITCH + (32 * ks + 8 * g) * 2); s[t] = MFMA16(a, qf[ks], s[t]); } }
        float mx = -INFINITY;
#pragma unroll
        for (int t = 0; t < 9; ++t)
#pragma unroll
            for (int r = 0; r < 4; ++r) { const int rel = 128 + q16 - 16 * t - 4 * g - r, kk = 16 * (wid + t) + 4 * g + r;
                const bool valid = (rel >= 0) && (rel <= maxback) && !(first && kk < 128);
                const float v = valid ? (s[t][r] * c1 - c2 * (float)rel) : -INFINITY; s[t][r] = v; mx = fmaxf(mx, v); }
        mx = fmaxf(mx, __shfl_xor(mx, 16)); mx = fmaxf(mx, __shfl_xor(mx, 32));
        mx = fmaxf(mx, sink2);
        float sum = 0.f;
#pragma unroll
        for (int t = 0; t < 9; ++t)
#pragma unroll
            for (int r = 0; r < 4; ++r) { const float e = __builtin_amdgcn_exp2f(s[t][r] - mx); s[t][r] = e; sum += e; }
        sum += __shfl_xor(sum, 16); sum += __shfl_xor(sum, 32);
        sum += __builtin_amdgcn_exp2f(sink2 - mx);
        bf16x8 pf[5];
#pragma unroll
        for (int uu = 0; uu < 5; ++uu) { u32x4 w; w.x = cvt_pk_bf16(s[2 * uu][0], s[2 * uu][1]); w.y = cvt_pk_bf16(s[2 * uu][2], s[2 * uu][3]);
            if (uu < 4) { w.z = cvt_pk_bf16(s[2 * uu + 1][0], s[2 * uu + 1][1]); w.w = cvt_pk_bf16(s[2 * uu + 1][2], s[2 * uu + 1][3]); } else { w.z = 0u; w.w = 0u; }
            pf[uu] = __builtin_bit_cast(bf16x8, w); }
        const unsigned vcom = (unsigned)(size_t)(lds + V_LDS) + (unsigned)((4 * g + (q16 >> 2)) * V_PITCH + (q16 & 3) * 8);
        unsigned vbase[9];
#pragma unroll
        for (int t = 0; t < 9; ++t) { const int T = wid + t; vbase[t] = vcom + (unsigned)((((T < 8) ? slotP : slotC) + (T & 7) * 16) * V_PITCH); }
        const float inv = 1.0f / sum;
        s16x4 lo[2][5], hi[2][4];
#pragma unroll
        for (int uu = 0; uu < 5; ++uu) { TRRD(lo[0][uu], vbase[2 * uu], 0); if (uu < 4) TRRD(hi[0][uu], vbase[2 * uu + 1], 0); }
#pragma unroll
        for (int dt = 0; dt < 8; ++dt) {
            const int S = dt & 1;
            if (dt + 1 < 8) {
#pragma unroll
                for (int uu = 0; uu < 5; ++uu) { TRRD(lo[S ^ 1][uu], vbase[2 * uu], 32 * (dt + 1)); if (uu < 4) TRRD(hi[S ^ 1][uu], vbase[2 * uu + 1], 32 * (dt + 1)); }
                asm volatile("s_waitcnt lgkmcnt(9)" : "+v"(lo[S][0]), "+v"(lo[S][1]), "+v"(lo[S][2]), "+v"(lo[S][3]), "+v"(lo[S][4]), "+v"(hi[S][0]), "+v"(hi[S][1]), "+v"(hi[S][2]), "+v"(hi[S][3]) :: "memory");
            } else {
                asm volatile("s_waitcnt lgkmcnt(0)" : "+v"(lo[S][0]), "+v"(lo[S][1]), "+v"(lo[S][2]), "+v"(lo[S][3]), "+v"(lo[S][4]), "+v"(hi[S][0]), "+v"(hi[S][1]), "+v"(hi[S][2]), "+v"(hi[S][3]) :: "memory");
            }
            f32x4 o = (f32x4){0.f, 0.f, 0.f, 0.f};
#pragma unroll
            for (int uu = 0; uu < 5; ++uu) { const bf16x8 vf = (uu < 4) ? __builtin_shufflevector(lo[S][uu], hi[S][uu], 0, 1, 2, 3, 4, 5, 6, 7) : __builtin_shufflevector(lo[S][4], lo[S][4], 0, 1, 2, 3, 4, 5, 6, 7);
                o = MFMA16(vf, pf[uu], o); }
            u32x2 w; w.x = cvt_pk_bf16(o[0] * inv, o[1] * inv); w.y = cvt_pk_bf16(o[2] * inv, o[3] * inv);
            *(u32x2*)(qrow + 16 * dt + 4 * g) = w;
        }
        if (cur.lse && g == 0) cur.lse[(size_t)qtok * 8] = (mx + __builtin_amdgcn_logf(sum)) * LN2;
        cur = nxt;
    }
    __syncthreads();
}
__device__ __forceinline__ void combine_phase(const Params& p) {
    const bf16_t* QA = (const bf16_t*)(p.ws + WS_QA); const float* LSE = (const float*)(p.ws + WS_LSE); bf16_t* OA = (bf16_t*)((unsigned char*)p.out + DO_OA);
    const int nthr = gridDim.x * 512;
    int tid = threadIdx.x; asm volatile("" : "+v"(tid));
#pragma unroll 4
    for (int idx = blockIdx.x * 512 + tid; idx < MT * 128; idx += nthr) {
        const int tok = idx >> 7, hc = idx & 127, h = hc >> 4, c = hc & 15;
        const float l0 = LSE[((size_t)0 * MT + tok) * 8 + h], l1 = LSE[((size_t)1 * MT + tok) * 8 + h], l2 = LSE[((size_t)2 * MT + tok) * 8 + h];
        const float mx = fmaxf(l0, fmaxf(l1, l2)); float w0 = __expf(l0 - mx), w1 = __expf(l1 - mx), w2 = __expf(l2 - mx); const float inv = 1.0f / (w0 + w1 + w2); w0 *= inv; w1 *= inv; w2 *= inv;
        const bf16_t* base = QA + (size_t)tok * 3072 + h * 128 + 8 * c;
        const u32x4 a = __builtin_nontemporal_load((const u32x4*)(base)), b = __builtin_nontemporal_load((const u32x4*)(base + 1024)), cc = __builtin_nontemporal_load((const u32x4*)(base + 2048));
        u32x4 o;
#pragma unroll
        for (int j = 0; j < 4; ++j) { const float lo = w0 * bf_lo(a[j]) + w1 * bf_lo(b[j]) + w2 * bf_lo(cc[j]), hi = w0 * bf_hi(a[j]) + w1 * bf_hi(b[j]) + w2 * bf_hi(cc[j]); o[j] = cvt_pk_bf16(lo, hi); }
        *(u32x4*)(OA + (size_t)tok * 1024 + h * 128 + 8 * c) = o;
    }
}

__device__ __forceinline__ void grid_bar(unsigned* ctr, unsigned target) {
    asm volatile("s_waitcnt vmcnt(0)" ::: "memory");
    __syncthreads();
    if (threadIdx.x == 0) {
        __builtin_amdgcn_fence(__ATOMIC_RELEASE, "agent");
        asm volatile("s_waitcnt vmcnt(0)" ::: "memory");
        __hip_atomic_fetch_add(ctr, 1u, __ATOMIC_RELAXED, __HIP_MEMORY_SCOPE_AGENT);
        while (__hip_atomic_load(ctr, __ATOMIC_RELAXED, __HIP_MEMORY_SCOPE_AGENT) < target) __builtin_amdgcn_s_sleep(2);
        __builtin_amdgcn_fence(__ATOMIC_ACQUIRE, "agent");
        asm volatile("s_waitcnt vmcnt(0)" ::: "memory");
    }
    __syncthreads();
}
__global__ void __launch_bounds__(512, 2) mega(Params p) {
    extern __shared__ __attribute__((aligned(16))) unsigned char lds[];
    cg::grid_group grid = cg::this_grid();
    PG8_LAS unsigned char* L = (PG8_LAS unsigned char*)lds;
    const int G = gridDim.x, c = blockIdx.x;
    unsigned* bar = (unsigned*)(p.ws + WS_BAR); unsigned* gbar = bar + 64 * (1 + (c & 7)); const bool grouped = (G % 8 == 0);
    unsigned char* ws = p.ws; unsigned char* ob = (unsigned char*)p.out;
    bf16_t* H = (bf16_t*)(ob + DO_H); bf16_t* WtIn = (bf16_t*)(ob + DO_WIN); bf16_t* OA = (bf16_t*)(ob + DO_OA);
    bf16_t* WtBa = (bf16_t*)(ws + WS_WBA); bf16_t* WtBb = (bf16_t*)(ws + WS_WBB); bf16_t* WtOut = (bf16_t*)(ws + WS_WOUT); bf16_t* WtF1 = (bf16_t*)(ws + WS_WFF1); bf16_t* WtF2 = (bf16_t*)(ws + WS_WFF2);
    bf16_t* MRG = (bf16_t*)(ws + WS_MRG); bf16_t* H2 = (bf16_t*)(ws + WS_H2); bf16_t* ACT = (bf16_t*)(ws + WS_ACT);
    transpose_convert(p.w_in, WtIn, DM, INC, nullptr, lds);
    rmsnorm_rows(p.x, p.norm1_g, H);
    grid.sync();
    { PG8_LAS float* gl = (PG8_LAS float*)(L + pg8::STAGE_BYTES + 8192); const int t = threadIdx.x;
      gl[t] = (t < 128) ? p.qna[t] : (t < 256) ? p.kna[t - 128] : (t < 384) ? p.qnb[t - 256] : p.knb[t - 384]; __syncthreads(); }
    { pg8::Gemm g{H, WtIn, MT, INC, DM}; pg8::StaticOrder S; S.init(MT, INC, G, c, 1);
      pg8::EpiProj E{(bf16_t*)(ws + WS_QA), (bf16_t*)(ws + WS_KA), (bf16_t*)(ws + WS_VA), (bf16_t*)(ws + WS_QB), (bf16_t*)(ws + WS_KB), (bf16_t*)(ws + WS_VB), (bf16_t*)(ws + WS_GA), (bf16_t*)(ws + WS_GB)};
      pg8::gemm_phase(L, g, S, E); }
    if (G == 256) { if (c >= 128) { transpose_convert_part(p.wba, WtBa, 1024, DM, lds, c - 128, 128); transpose_convert_part(p.wbb, WtBb, DM, DM, lds, c - 128, 128); } }
    else { transpose_convert(p.wba, WtBa, 1024, DM, nullptr, lds); transpose_convert(p.wbb, WtBb, DM, DM, nullptr, lds); }
    grid_bar(bar, 1u * (unsigned)G);
    attn_phase(p, lds);
    grid_bar(bar, 2u * (unsigned)G);
    transpose_convert(p.wff2, WtF2, DFF, DM, nullptr, lds);
    transpose_convert(p.wff1, WtF1, DM, DFF, p.norm2_g, lds);
    transpose_convert(p.wout, WtOut, DM, DM, nullptr, lds);
    combine_phase(p);
    grid_bar(bar, 3u * (unsigned)G);
    { pg8::Gemm g{OA, WtBa, MT, DM, 1024}; pg8::StaticOrder S; S.init(MT, DM, G, c);
      pg8::EpiGate E{(const bf16_t*)(ws + WS_GA), nullptr, MRG, DM}; pg8::gemm_phase(L, g, S, E); }
    { pg8::Gemm g{(const bf16_t*)(ws + WS_QB), WtBb, MT, DM, DM}; pg8::StaticOrder S; S.init(MT, DM, G, c);
      pg8::EpiGate E{(const bf16_t*)(ws + WS_GB), MRG, MRG, DM}; pg8::gemm_phase(L, g, S, E); }
    if (grouped) grid_bar(gbar, 1u * (unsigned)(G >> 3)); else grid_bar(bar, 4u * (unsigned)G);
    { pg8::Gemm g{MRG, WtOut, MT, DM, DM}; pg8::StaticOrder S; S.init(MT, DM, G, c);
      pg8::EpiResX1 E{p.x, H2, (float*)(ws + WS_SSQ), DM}; pg8::gemm_phase(L, g, S, E); }
    grid_bar(bar, (grouped ? 4u : 5u) * (unsigned)G);
    { pg8::Gemm g{H2, WtF1, MT, DFF, DM}; pg8::StaticOrder S; S.init(MT, DFF, G, c, 1);
      pg8::Unit u0; if (S.next(0, u0)) { PG8_LAS float* RS = (PG8_LAS float*)(L + pg8::STAGE_BYTES + 8192 + 2048); const int t = threadIdx.x;
          if (t < 256) { const float* sp = (const float*)(ws + WS_SSQ) + (size_t)(u0.pm * 256 + t) * 8; const f32x4 p0 = *(const f32x4*)sp, p1 = *(const f32x4*)(sp + 4);
              RS[t] = rsqrtf((((p0[0] + p0[1]) + (p0[2] + p0[3])) + ((p1[0] + p1[1]) + (p1[2] + p1[3]))) * (1.0f / 2048.0f) + 1e-6f); } }
      __syncthreads();
      pg8::EpiRelu2 E{ACT, ACT_LD}; pg8::gemm_phase(L, g, S, E); }
    if (grouped) grid_bar(gbar, 2u * (unsigned)(G >> 3)); else grid_bar(bar, 6u * (unsigned)G);
    { pg8::Gemm g{ACT, WtF2, MT, DM, DFF, ACT_LD}; pg8::StaticOrder S; S.init(MT, DM, G, c);
      pg8::EpiFinal E{H2, p.out, DM}; pg8::gemm_phase(L, g, S, E); }
}

extern "C" void kernel_launch(void* const* d_in, const int* in_sizes, int n_in, void* d_out, int out_size, void* d_ws, size_t ws_size, hipStream_t stream) {
    static int grid_blocks = 0;
    if (!grid_blocks) {
        if (n_in != 14 || out_size != MT * DM || ws_size < WS_NEED) { fprintf(stderr, "kernel_launch: unexpected shapes (n_in %d out %d ws %zu)\n", n_in, out_size, ws_size); grid_blocks = -1; return; }
        int dev = 0, cus = 0, per_cu = 0;
        (void)hipGetDevice(&dev); (void)hipDeviceGetAttribute(&cus, hipDeviceAttributeMultiprocessorCount, dev);
        if (hipFuncSetAttribute((const void*)mega, hipFuncAttributeMaxDynamicSharedMemorySize, LDS_BYTES) != hipSuccess) { fprintf(stderr, "kernel_launch: hipFuncSetAttribute failed\n"); grid_blocks = -1; return; }
        (void)hipOccupancyMaxActiveBlocksPerMultiprocessor(&per_cu, (const void*)mega, 512, LDS_BYTES);
        if (per_cu < 1) { fprintf(stderr, "kernel_launch: occupancy query says %d blocks/CU\n", per_cu); }
        (void)hipGetLastError();
        if (cus % 64 != 0) { fprintf(stderr, "kernel_launch: built for a CU count that is a multiple of 64 (MI355X: 256), got %d; nothing launched\n", cus); grid_blocks = -1; return; }
        grid_blocks = cus;
    }
    if (grid_blocks < 0) return;
    Params p{};
    p.x = (const float*)d_in[0]; p.norm1_g = (const float*)d_in[1]; p.w_in = (const float*)d_in[2]; p.qna = (const float*)d_in[3]; p.kna = (const float*)d_in[4];
    p.qnb = (const float*)d_in[5]; p.knb = (const float*)d_in[6]; p.sinks = (const float*)d_in[7]; p.wba = (const float*)d_in[8]; p.wbb = (const float*)d_in[9];
    p.wout = (const float*)d_in[10]; p.norm2_g = (const float*)d_in[11]; p.wff1 = (const float*)d_in[12]; p.wff2 = (const float*)d_in[13];
    p.out = (float*)d_out; p.ws = (unsigned char*)d_ws;
    if (hipMemsetAsync((unsigned char*)d_ws + WS_BAR, 0, 4096, stream) != hipSuccess) { fprintf(stderr, "kernel_launch: memset of the barrier word failed\n"); return; }
    void* args[] = {&p};
    hipError_t e = hipLaunchCooperativeKernel((const void*)mega, dim3(grid_blocks), dim3(512), args, LDS_BYTES, stream);
    if (e != hipSuccess) fprintf(stderr, "cooperative launch failed: %s (grid %d)\n", hipGetErrorString(e), grid_blocks);
}
```

```cpp
#include <hip/hip_runtime.h>
#include <hip/hip_cooperative_groups.h>
#include <cstdio>
namespace cg = cooperative_groups;

namespace pg8 {
#define PG8_LAS __attribute__((address_space(3)))
typedef unsigned short bf16_t;
typedef short bf16x8 __attribute__((ext_vector_type(8)));
typedef float f32x4 __attribute__((ext_vector_type(4)));
typedef unsigned u32x4 __attribute__((ext_vector_type(4)));
constexpr int BM = 256, BK = 64, HALF = 128, HTB = HALF * BK * 2  , STAGE_BYTES = 8 * HTB, NXCD = 8, WGM = 8;

__host__ __device__ __forceinline__ int lds_byte(int r, int c) { const int st = (r >> 4) * 2 + (c >> 5), rr = r & 15, cc = c & 31, ob = rr * 64 + cc * 2; return st * 1024 + (ob ^ (((ob >> 9) & 1) << 5)); }
__host__ __device__ __forceinline__ void stage_rc(int b, int& R, int& C) { const int st = b / 1024, sb = b % 1024, swz = sb ^ (((sb >> 9) & 1) << 5); R = (st >> 1) * 16 + swz / 64; C = (st & 1) * 32 + (swz % 64) / 2; }
__host__ __device__ __forceinline__ int perm32(int rho) { const int n = rho >> 4, i = rho & 15; return 8 * (i >> 2) + 4 * n + (i & 3); }

struct Unit { int pm, pn; };
struct Gemm { const bf16_t* A; const bf16_t* Bt; int M, N, K; int lda = 0; };

struct StaticOrder {
    int nM, nN, nwg, G, c, flip;
    __host__ __device__ void init(int M, int N, int G_, int c_, int flip_ = 0) { nM = M / BM; nN = N / BM; nwg = nM * nN; G = G_; c = c_; flip = flip_; }
    __host__ __device__ bool next(int i, Unit& u) const {
        const long L = (long)i * G + c; if (L >= nwg) return false;
        int wgid = (int)L; { const int q = nwg / NXCD, r = nwg % NXCD, xcd = wgid % NXCD, off = wgid / NXCD; wgid = (xcd < r ? xcd * (q + 1) : r * (q + 1) + (xcd - r) * q) + off; }
        const int nig = WGM * nN, gid = wgid / nig, fm = gid * WGM, gsz = (nM - fm) < WGM ? (nM - fm) : WGM;
        u.pm = fm + ((wgid % nig) % gsz); u.pn = (wgid % nig) / gsz; if (flip) u.pn = nN - 1 - u.pn; return true;
    }
    __device__ __forceinline__ void a_ready(const Unit&) const {}
    __device__ __forceinline__ void done(const Unit&) const {}
};
__device__ __forceinline__ unsigned cvt_pk_bf16(float lo, float hi) { unsigned r; asm("v_cvt_pk_bf16_f32 %0, %1, %2" : "=v"(r) : "v"(lo), "v"(hi)); return r; }
typedef float f32x2 __attribute__((ext_vector_type(2)));
typedef unsigned u32x2 __attribute__((ext_vector_type(2)));
__device__ __forceinline__ float bf_lo(unsigned w) { return __uint_as_float(w << 16); }
__device__ __forceinline__ float bf_hi(unsigned w) { return __uint_as_float(w & 0xffff0000u); }

struct EpiProj {
    static constexpr bool PERM = true, AFTER_DRAIN = false;
    bf16_t *QA, *KA, *VA, *QB, *KB, *VB, *GA, *GB;
    __device__ __forceinline__ void operator()(const f32x4 (&acc)[2][2][4][2], const Unit& u, int wr, int wc, int fr, int fq, PG8_LAS unsigned char* xl) const {
        const int pn = u.pn; int mode, ldc, colt; bf16_t* base; int gsel = 0;
        if (pn < 12)       { mode = 1; base = QA; ldc = 3072; colt = pn * 256; gsel = 0; }
        else if (pn < 24)  { mode = 1; base = KA; ldc = 3072; colt = (pn - 12) * 256; gsel = 1; }
        else if (pn < 36)  { mode = 0; base = VA; ldc = 3072; colt = (pn - 24) * 256; }
        else if (pn < 44)  { mode = 1; base = QB; ldc = 2048; colt = (pn - 36) * 256; gsel = 2; }
        else if (pn == 44) { mode = 1; base = KB; ldc = 256; colt = 0; gsel = 3; }
        else if (pn == 45) { mode = 0; base = VB; ldc = 256; colt = 0; }
        else if (pn < 54)  { mode = 2; base = GA; ldc = 2048; colt = (pn - 46) * 256; }
        else               { mode = 2; base = GB; ldc = 2048; colt = (pn - 54) * 256; }
        const int row0 = u.pm * BM + wr * 64 + fr, col0 = colt + wc * 32 + 8 * fq;
        if (mode == 1) {
            PG8_LAS float* T = (PG8_LAS float*)xl;
#pragma unroll
            for (int ai = 0; ai < 2; ++ai)
#pragma unroll
                for (int m = 0; m < 4; ++m)
#pragma unroll
                    for (int bj = 0; bj < 2; ++bj) {
                        const f32x4 a = acc[ai][bj][m][0], b = acc[ai][bj][m][1];
                        float s = (a[0] * a[0] + a[1] * a[1]) + (a[2] * a[2] + a[3] * a[3]) + (b[0] * b[0] + b[1] * b[1]) + (b[2] * b[2] + b[3] * b[3]);
                        s += __shfl_xor(s, 16); s += __shfl_xor(s, 32);
                        if (fq == 0) T[((ai * HALF + wr * 64 + m * 16 + fr) * 2 + bj) * 4 + wc] = s;
                    }
            asm volatile("s_waitcnt lgkmcnt(0)" ::: "memory"); __builtin_amdgcn_s_barrier(); asm volatile("" ::: "memory");
            const PG8_LAS float* gl = (const PG8_LAS float*)(xl + 8192) + gsel * 128 + wc * 32 + 8 * fq;
            const f32x4 g0 = *(const PG8_LAS f32x4*)gl, g1 = *(const PG8_LAS f32x4*)(gl + 4);
#pragma unroll
            for (int ai = 0; ai < 2; ++ai)
#pragma unroll
                for (int m = 0; m < 4; ++m) { bf16_t* rowp = base + (size_t)(row0 + ai * HALF + m * 16) * ldc + col0;
#pragma unroll
                    for (int bj = 0; bj < 2; ++bj) {
                        const f32x4 t = *(const PG8_LAS f32x4*)(T + ((ai * HALF + wr * 64 + m * 16 + fr) * 2 + bj) * 4);
                        const float rs = rsqrtf(((t[0] + t[1]) + (t[2] + t[3])) * (1.0f / 128.0f) + 1e-6f);
                        const f32x4 v0 = acc[ai][bj][m][0] * rs * g0, v1 = acc[ai][bj][m][1] * rs * g1;
                        u32x4 w; w.x = cvt_pk_bf16(v0[0], v0[1]); w.y = cvt_pk_bf16(v0[2], v0[3]); w.z = cvt_pk_bf16(v1[0], v1[1]); w.w = cvt_pk_bf16(v1[2], v1[3]);
                        *(u32x4*)(rowp + bj * HALF) = w; } }
        } else {
#pragma unroll
            for (int ai = 0; ai < 2; ++ai)
#pragma unroll
                for (int m = 0; m < 4; ++m) { bf16_t* rowp = base + (size_t)(row0 + ai * HALF + m * 16) * ldc + col0;
#pragma unroll
                    for (int bj = 0; bj < 2; ++bj) { f32x4 v0 = acc[ai][bj][m][0], v1 = acc[ai][bj][m][1];
                        if (mode == 2) {
#pragma unroll
                            for (int j = 0; j < 4; ++j) { v0[j] = __builtin_amdgcn_rcpf(1.0f + __expf(-v0[j])); v1[j] = __builtin_amdgcn_rcpf(1.0f + __expf(-v1[j])); } }
                        u32x4 w; w.x = cvt_pk_bf16(v0[0], v0[1]); w.y = cvt_pk_bf16(v0[2], v0[3]); w.z = cvt_pk_bf16(v1[0], v1[1]); w.w = cvt_pk_bf16(v1[2], v1[3]);
                        if (mode == 2) __builtin_nontemporal_store(w, (u32x4*)(rowp + bj * HALF)); else *(u32x4*)(rowp + bj * HALF) = w; } }
        }
    }
};
struct EpiGate {
    static constexpr bool PERM = true, AFTER_DRAIN = false;
    const bf16_t* G; const bf16_t* addend; bf16_t* out; int ldc;
    __device__ __forceinline__ void operator()(const f32x4 (&acc)[2][2][4][2], const Unit& u, int wr, int wc, int fr, int fq, PG8_LAS unsigned char*) const {
        const int row0 = u.pm * BM + wr * 64 + fr, col0 = u.pn * BM + wc * 32 + 8 * fq;
#pragma unroll
        for (int ai = 0; ai < 2; ++ai)
#pragma unroll
            for (int m = 0; m < 4; ++m) { const size_t roff = (size_t)(row0 + ai * HALF + m * 16) * ldc + col0;
#pragma unroll
                for (int bj = 0; bj < 2; ++bj) { const size_t off = roff + bj * HALF;
                    const u32x4 gw = __builtin_nontemporal_load((const u32x4*)(G + off));     f32x4 v0 = acc[ai][bj][m][0], v1 = acc[ai][bj][m][1];
                    v0[0] *= bf_lo(gw.x); v0[1] *= bf_hi(gw.x); v0[2] *= bf_lo(gw.y); v0[3] *= bf_hi(gw.y);
                    v1[0] *= bf_lo(gw.z); v1[1] *= bf_hi(gw.z); v1[2] *= bf_lo(gw.w); v1[3] *= bf_hi(gw.w);
                    if (addend) { const u32x4 aw = *(const u32x4*)(addend + off);
                        v0[0] += bf_lo(aw.x); v0[1] += bf_hi(aw.x); v0[2] += bf_lo(aw.y); v0[3] += bf_hi(aw.y);
                        v1[0] += bf_lo(aw.z); v1[1] += bf_hi(aw.z); v1[2] += bf_lo(aw.w); v1[3] += bf_hi(aw.w); }
                    u32x4 w; w.x = cvt_pk_bf16(v0[0], v0[1]); w.y = cvt_pk_bf16(v0[2], v0[3]); w.z = cvt_pk_bf16(v1[0], v1[1]); w.w = cvt_pk_bf16(v1[2], v1[3]);
                    *(u32x4*)(out + off) = w; } }
    }
};
struct EpiResF32 {
    static constexpr bool PERM = true, AFTER_DRAIN = false;
    const float* res; float* out; int ldc;
    __device__ __forceinline__ void operator()(const f32x4 (&acc)[2][2][4][2], const Unit& u, int wr, int wc, int fr, int fq, PG8_LAS unsigned char*) const {
        const int row0 = u.pm * BM + wr * 64 + fr, col0 = u.pn * BM + wc * 32 + 8 * fq;
#pragma unroll
        for (int ai = 0; ai < 2; ++ai)
#pragma unroll
            for (int m = 0; m < 4; ++m) { const size_t roff = (size_t)(row0 + ai * HALF + m * 16) * ldc + col0;
#pragma unroll
                for (int bj = 0; bj < 2; ++bj)
#pragma unroll
                    for (int n = 0; n < 2; ++n) { const size_t off = roff + bj * HALF + n * 4; const f32x4 r = *(const f32x4*)(res + off); *(f32x4*)(out + off) = r + acc[ai][bj][m][n]; } }
    }
};
struct EpiResX1 {
    static constexpr bool PERM = true, AFTER_DRAIN = false;
    const float* res; bf16_t* xb; float* ssqp; int ldc;
    __device__ __forceinline__ void operator()(const f32x4 (&acc)[2][2][4][2], const Unit& u, int wr, int wc, int fr, int fq, PG8_LAS unsigned char* xl) const {
        const int row0 = u.pm * BM + wr * 64 + fr, col0 = u.pn * BM + wc * 32 + 8 * fq;
        PG8_LAS float* T = (PG8_LAS float*)xl;
#pragma unroll
        for (int ai = 0; ai < 2; ++ai)
#pragma unroll
            for (int m = 0; m < 4; ++m) { const size_t roff = (size_t)(row0 + ai * HALF + m * 16) * ldc + col0; float s = 0.f;
#pragma unroll
                for (int bj = 0; bj < 2; ++bj) { const size_t off = roff + bj * HALF;
                    const f32x4 v0 = __builtin_nontemporal_load((const f32x4*)(res + off)) + acc[ai][bj][m][0], v1 = __builtin_nontemporal_load((const f32x4*)(res + off + 4)) + acc[ai][bj][m][1];
                    u32x4 w; w.x = cvt_pk_bf16(v0[0], v0[1]); w.y = cvt_pk_bf16(v0[2], v0[3]); w.z = cvt_pk_bf16(v1[0], v1[1]); w.w = cvt_pk_bf16(v1[2], v1[3]);
                    *(u32x4*)(xb + off) = w;
                    s += (v0[0] * v0[0] + v0[1] * v0[1]) + (v0[2] * v0[2] + v0[3] * v0[3]) + (v1[0] * v1[0] + v1[1] * v1[1]) + (v1[2] * v1[2] + v1[3] * v1[3]); }
                s += __shfl_xor(s, 16); s += __shfl_xor(s, 32);
                if (fq == 0) T[(ai * HALF + wr * 64 + m * 16 + fr) * 4 + wc] = s; }
        asm volatile("s_waitcnt lgkmcnt(0)" ::: "memory"); __builtin_amdgcn_s_barrier(); asm volatile("" ::: "memory");
        if (wc == 0 && fq == 0) {
#pragma unroll
            for (int ai = 0; ai < 2; ++ai)
#pragma unroll
                for (int m = 0; m < 4; ++m) { const int r = ai * HALF + wr * 64 + m * 16 + fr; const f32x4 t = *(const PG8_LAS f32x4*)(T + r * 4);
                    ssqp[(size_t)(u.pm * BM + r) * 8 + u.pn] = (t[0] + t[1]) + (t[2] + t[3]); } }
    }
};
struct EpiFinal {
    static constexpr bool PERM = true, AFTER_DRAIN = false;
    const bf16_t* res; float* out; int ldc;
    __device__ __forceinline__ void operator()(const f32x4 (&acc)[2][2][4][2], const Unit& u, int wr, int wc, int fr, int fq, PG8_LAS unsigned char*) const {
        const int row0 = u.pm * BM + wr * 64 + fr, col0 = u.pn * BM + wc * 32 + 8 * fq;
#pragma unroll
        for (int ai = 0; ai < 2; ++ai)
#pragma unroll
            for (int m = 0; m < 4; ++m) { const size_t roff = (size_t)(row0 + ai * HALF + m * 16) * ldc + col0;
#pragma unroll
                for (int bj = 0; bj < 2; ++bj) { const size_t off = roff + bj * HALF; const u32x4 rw = __builtin_nontemporal_load((const u32x4*)(res + off));
                    f32x4 v0 = acc[ai][bj][m][0], v1 = acc[ai][bj][m][1];
                    v0[0] += bf_lo(rw.x); v0[1] += bf_hi(rw.x); v0[2] += bf_lo(rw.y); v0[3] += bf_hi(rw.y);
                    v1[0] += bf_lo(rw.z); v1[1] += bf_hi(rw.z); v1[2] += bf_lo(rw.w); v1[3] += bf_hi(rw.w);
                    __builtin_nontemporal_store(v0, (f32x4*)(out + off)); __builtin_nontemporal_store(v1, (f32x4*)(out + off + 4)); } }
    }
};
struct EpiRelu2 {
    static constexpr bool PERM = true, AFTER_DRAIN = false;
    bf16_t* out; int ldc;
    __device__ __forceinline__ void operator()(const f32x4 (&acc)[2][2][4][2], const Unit& u, int wr, int wc, int fr, int fq, PG8_LAS unsigned char* xl) const {
        const int row0 = u.pm * BM + wr * 64 + fr, col0 = u.pn * BM + wc * 32 + 8 * fq;
        const PG8_LAS float* RS = (const PG8_LAS float*)(xl + 8192 + 2048);
#pragma unroll
        for (int ai = 0; ai < 2; ++ai)
#pragma unroll
            for (int m = 0; m < 4; ++m) { const int rl = wr * 64 + fr + ai * HALF + m * 16; bf16_t* rowp = out + (size_t)(u.pm * BM + rl) * ldc + col0;
                const float rs = RS[rl];
#pragma unroll
                for (int bj = 0; bj < 2; ++bj) { f32x4 v0 = acc[ai][bj][m][0], v1 = acc[ai][bj][m][1];
#pragma unroll
                    for (int j = 0; j < 4; ++j) { const float a = fmaxf(v0[j] * rs, 0.f), b = fmaxf(v1[j] * rs, 0.f); v0[j] = a * a; v1[j] = b * b; }
                    u32x4 w; w.x = cvt_pk_bf16(v0[0], v0[1]); w.y = cvt_pk_bf16(v0[2], v0[3]); w.z = cvt_pk_bf16(v1[0], v1[1]); w.w = cvt_pk_bf16(v1[2], v1[3]);
                    *(u32x4*)(rowp + bj * HALF) = w; } }
    }
};

template <class Epi, class Sched>
__device__ __forceinline__ void gemm_phase(PG8_LAS unsigned char* lds, const Gemm g, const Sched& S, const Epi& E) {
    int tid = threadIdx.x; asm volatile("" : "+v"(tid));
    const int wid = __builtin_amdgcn_readfirstlane(tid >> 6), lane = tid & 63, wr = wid >> 2, wc = wid & 3, fr = lane & 15, fq = lane >> 4;
    const int K = g.K, nt = K / BK;
    const int lda = g.lda ? g.lda : K;
    unsigned voffA[2], voffB[2];
#pragma unroll
    for (int i = 0; i < 2; ++i) { int R, C; stage_rc(tid * 16 + i * 8192, R, C); const int Rb = Epi::PERM ? ((R & ~31) + perm32(R & 31)) : R;
        voffA[i] = (unsigned)(R * lda + C) * 2u; voffB[i] = (unsigned)(Rb * K + C) * 2u; }
    const size_t kstep = (size_t)(BK * 2);
    const size_t hstepA = (size_t)HALF * lda * 2, hstepB = (size_t)HALF * K * 2;
    const size_t tstepA = 2 * hstepA, tstepB = 2 * hstepB;
    const unsigned ldsw = (unsigned)wid * 1024u;
    const int aoff = lds_byte(wr * 64 + fr, fq * 8), boff = lds_byte(wc * 32 + fr, fq * 8);
#define PG8_SA(b, h) (((b) * 2 + (h)) * HTB)
#define PG8_SB(b, h) ((4 + (b) * 2 + (h)) * HTB)
#define PG8_STAGE(bufoff, gbase, voff) do { _Pragma("unroll") for (int _i = 0; _i < 2; ++_i) \
        __builtin_amdgcn_global_load_lds((const unsigned*)((const char*)(gbase) + (voff)[_i]), (PG8_LAS unsigned*)(lds + (bufoff) + ldsw + _i * 8192), 16, 0, 0); } while (0)
#define PG8_LDA(dst, b, h) do { _Pragma("unroll") for (int m = 0; m < 4; ++m) _Pragma("unroll") for (int k = 0; k < 2; ++k) dst[m][k] = *(const PG8_LAS bf16x8*)(lds + PG8_SA(b, h) + aoff + m * 2048 + k * 1024); } while (0)
#define PG8_LDB(dst, b, h) do { _Pragma("unroll") for (int n = 0; n < 2; ++n) _Pragma("unroll") for (int k = 0; k < 2; ++k) dst[n][k] = *(const PG8_LAS bf16x8*)(lds + PG8_SB(b, h) + boff + n * 2048 + k * 1024); } while (0)
#define PG8_MMA(ai, bj, At, Bt) do { __builtin_amdgcn_s_setprio(1); _Pragma("unroll") for (int m = 0; m < 4; ++m) _Pragma("unroll") for (int n = 0; n < 2; ++n) _Pragma("unroll") for (int k = 0; k < 2; ++k) \
        acc[ai][bj][m][n] = __builtin_amdgcn_mfma_f32_16x16x32_bf16(Bt[n][k], At[m][k], acc[ai][bj][m][n], 0, 0, 0); __builtin_amdgcn_s_setprio(0); } while (0)
#define PG8_WAIT_V(n) asm volatile("s_waitcnt vmcnt(" #n ")" ::: "memory")
#define PG8_WAIT_L(n) asm volatile("s_waitcnt lgkmcnt(" #n ")" ::: "memory")
#define PG8_BAR __builtin_amdgcn_s_barrier()
#define PG8_SCHED __builtin_amdgcn_sched_barrier(0)
    Unit cur, nxt; int ui = 0;
    if (!S.next(0, cur)) return;
    f32x4 acc[2][2][4][2];
#pragma unroll
    for (int a = 0; a < 2; ++a)
#pragma unroll
        for (int b = 0; b < 2; ++b)
#pragma unroll
            for (int m = 0; m < 4; ++m)
#pragma unroll
                for (int n = 0; n < 2; ++n) acc[a][b][m][n] = (f32x4){0.f, 0.f, 0.f, 0.f};
    bf16x8 At[4][2], B0[2][2], B1[2][2];
    const char* cA = (const char*)g.A + (size_t)cur.pm * tstepA; const char* cB = (const char*)g.Bt + (size_t)cur.pn * tstepB;
    S.a_ready(cur);
    PG8_STAGE(PG8_SB(0, 0), cB, voffB); PG8_STAGE(PG8_SA(0, 0), cA, voffA); PG8_STAGE(PG8_SB(0, 1), cB + hstepB, voffB); PG8_STAGE(PG8_SA(0, 1), cA + hstepA, voffA);
    if (wr == 1) PG8_BAR;
    PG8_WAIT_V(4); PG8_BAR;
    PG8_STAGE(PG8_SB(1, 0), cB + kstep, voffB); PG8_STAGE(PG8_SA(1, 0), cA + kstep, voffA); PG8_STAGE(PG8_SB(1, 1), cB + hstepB + kstep, voffB);
    PG8_WAIT_V(6); PG8_BAR;
    for (;;) {
        const bool has_next = S.next(ui + 1, nxt);
        const char* nA = has_next ? (const char*)g.A + (size_t)nxt.pm * tstepA : cA; const char* nB = has_next ? (const char*)g.Bt + (size_t)nxt.pn * tstepB : cB;
        for (int t = 0; t < nt; t += 2) {
            const bool last = (t == nt - 2);
            const char* a1 = cA + (size_t)(t + 1) * kstep;
            const char* a2 = last ? nA : cA + (size_t)(t + 2) * kstep; const char* b2 = last ? nB : cB + (size_t)(t + 2) * kstep;
            const char* a3 = a2 + kstep; const char* b3 = b2 + kstep;
            if (last && has_next) S.a_ready(nxt);
            PG8_LDB(B0, 0, 0); PG8_SCHED; PG8_LDA(At, 0, 0); PG8_STAGE(PG8_SA(1, 1), a1 + hstepA, voffA);
            PG8_WAIT_L(8); PG8_BAR; PG8_WAIT_L(0); PG8_MMA(0, 0, At, B0); PG8_BAR; PG8_SCHED;
            PG8_LDB(B1, 0, 1); PG8_STAGE(PG8_SB(0, 0), b2, voffB);
            PG8_BAR; PG8_WAIT_L(0); PG8_MMA(0, 1, At, B1); PG8_BAR;
            PG8_LDA(At, 0, 1); PG8_STAGE(PG8_SA(0, 0), a2, voffA);
            PG8_BAR; PG8_WAIT_L(0); PG8_MMA(1, 0, At, B0); PG8_BAR; PG8_SCHED;
            PG8_STAGE(PG8_SB(0, 1), b2 + hstepB, voffB);
            PG8_WAIT_V(6); PG8_BAR; PG8_MMA(1, 1, At, B1); PG8_BAR;
            PG8_LDB(B0, 1, 0); PG8_SCHED; PG8_LDA(At, 1, 0); PG8_STAGE(PG8_SA(0, 1), a2 + hstepA, voffA);
            PG8_WAIT_L(8); PG8_BAR; PG8_WAIT_L(0); PG8_MMA(0, 0, At, B0); PG8_BAR; PG8_SCHED;
            PG8_LDB(B1, 1, 1); PG8_STAGE(PG8_SB(1, 0), b3, voffB);
            PG8_BAR; PG8_WAIT_L(0); PG8_MMA(0, 1, At, B1); PG8_BAR;
            PG8_LDA(At, 1, 1); PG8_STAGE(PG8_SA(1, 0), a3, voffA);
            PG8_BAR; PG8_WAIT_L(0); PG8_MMA(1, 0, At, B0); PG8_BAR; PG8_SCHED;
            PG8_STAGE(PG8_SB(1, 1), b3 + hstepB, voffB);
            PG8_WAIT_V(6); PG8_BAR; PG8_MMA(1, 1, At, B1); PG8_BAR;
        }
        E(acc, cur, wr, wc, fr, fq, lds + STAGE_BYTES); S.done(cur);
        if (!has_next) break;
#pragma unroll
        for (int a = 0; a < 2; ++a)
#pragma unroll
            for (int b = 0; b < 2; ++b)
#pragma unroll
                for (int m = 0; m < 4; ++m)
#pragma unroll
                    for (int n = 0; n < 2; ++n) acc[a][b][m][n] = (f32x4){0.f, 0.f, 0.f, 0.f};
        cur = nxt; cA = nA; cB = nB; ++ui;
    }
    PG8_WAIT_V(0);
    if (wr == 0) PG8_BAR;
    PG8_BAR;
#undef PG8_SA
#undef PG8_SB
#undef PG8_STAGE
#undef PG8_LDA
#undef PG8_LDB
#undef PG8_MMA
#undef PG8_WAIT_V
#undef PG8_WAIT_L
#undef PG8_BAR
#undef PG8_SCHED
}
}

using pg8::bf16_t; using pg8::bf16x8; using pg8::f32x4; using pg8::u32x4; using pg8::u32x2; using pg8::cvt_pk_bf16; using pg8::bf_lo; using pg8::bf_hi;
#define LAS __attribute__((address_space(3)))
typedef short s16x4 __attribute__((ext_vector_type(4)));
constexpr int MT = 16384, TSEQ = 8192, DM = 2048, INC = 15872, DFF = 8192, ACT_LD = DFF + 64;
constexpr size_t MiB = (size_t)1 << 20;
constexpr size_t WS_KA = 0, WS_QA = 96 * MiB, WS_VA = 192 * MiB, WS_QB = 288 * MiB, WS_KB = 352 * MiB, WS_VB = 360 * MiB, WS_GA = 368 * MiB, WS_GB = 432 * MiB,
                 WS_WBA = 496 * MiB, WS_WBB = 500 * MiB, WS_LSE = 508 * MiB, WS_SSQ = 510 * MiB, WS_BAR = 511 * MiB, WS_NEED = 512 * MiB;
constexpr size_t WS_WOUT = 0, WS_WFF1 = 8 * MiB, WS_WFF2 = 40 * MiB;
constexpr size_t WS_MRG = WS_VA, WS_H2 = WS_QA, WS_ACT = 192 * MiB;
constexpr size_t DO_H = 0, DO_WIN = 64 * MiB, DO_OA = 0;
constexpr int LDS_BYTES = 144 * 1024;
constexpr int K_PITCH = 272, V_PITCH = 288, K_LDS = 0, V_LDS = 256 * K_PITCH;

struct Params {
    const float *x, *norm1_g, *w_in, *qna, *kna, *qnb, *knb, *sinks, *wba, *wbb, *wout, *norm2_g, *wff1, *wff2;
    float* out; unsigned char* ws;
};

#define TRRD(dst, base, off) asm volatile("ds_read_b64_tr_b16 %0, %1 offset:%2" : "=&v"(dst) : "v"(base), "i"(off) : "memory")
__device__ __forceinline__ void transpose_convert_impl(const float* __restrict__ W, bf16_t* __restrict__ Wt, int K, int N, const float* __restrict__ kgain, unsigned char* lds_g, const int t_first, const int t_stride) {
    LAS unsigned char* lds = (LAS unsigned char*)lds_g;
    int tid = threadIdx.x; asm volatile("" : "+v"(tid));
    const int lane = tid & 63, w = tid >> 6, c = tid & 31, r = tid >> 5;
    const int tiles_n = N >> 7, nt = tiles_n * (K >> 7);
    const int gg = lane >> 4, i16 = lane & 15, q = i16 >> 2, pp = i16 & 3;
    const int nb = 2 * (w & 3) + (gg & 1), kb0 = (gg >> 1) + 8 * (w >> 2);
    const unsigned rd = (unsigned)(size_t)lds + (unsigned)((8 * kb0 + q) * 320 + (16 * nb + 4 * pp) * 2);
    f32x4 v[8];
    int t = t_first;
    if (t < nt) { const int tk = t / tiles_n, tn = t - tk * tiles_n; const float* src = W + (size_t)((tk << 7) + r) * N + (tn << 7) + 4 * c;
#pragma unroll
        for (int i = 0; i < 8; ++i) v[i] = __builtin_nontemporal_load((const f32x4*)(src + (size_t)(16 * i) * N));     }
    for (; t < nt; t += t_stride) {
        const int tk = t / tiles_n, tn = t - tk * tiles_n, k0 = tk << 7, n0 = tn << 7;
#pragma unroll
        for (int i = 0; i < 8; ++i) { const float g = kgain ? kgain[k0 + r + 16 * i] : 1.0f; u32x2 wv; wv.x = cvt_pk_bf16(v[i][0] * g, v[i][1] * g); wv.y = cvt_pk_bf16(v[i][2] * g, v[i][3] * g);
            *(LAS u32x2*)(lds + (r + 16 * i) * 320 + 8 * c) = wv; }
        const int t2 = t + t_stride;
        if (t2 < nt) { const int tk2 = t2 / tiles_n, tn2 = t2 - tk2 * tiles_n; const float* src = W + (size_t)((tk2 << 7) + r) * N + (tn2 << 7) + 4 * c;
#pragma unroll
            for (int i = 0; i < 8; ++i) v[i] = __builtin_nontemporal_load((const f32x4*)(src + (size_t)(16 * i) * N));     }
        __syncthreads();
        s16x4 lo[4], hi[4];
#pragma unroll
        for (int jj = 0; jj < 4; ++jj) { TRRD(lo[jj], rd, (16 * jj) * 320); TRRD(hi[jj], rd, (16 * jj + 4) * 320); }
        asm volatile("s_waitcnt lgkmcnt(0)" : "+v"(lo[0]), "+v"(lo[1]), "+v"(lo[2]), "+v"(lo[3]), "+v"(hi[0]), "+v"(hi[1]), "+v"(hi[2]), "+v"(hi[3]) :: "memory");
        bf16_t* dst = Wt + (size_t)(n0 + 16 * nb + i16) * K + k0 + 8 * kb0;
#pragma unroll
        for (int jj = 0; jj < 4; ++jj) *(bf16x8*)(dst + 16 * jj) = __builtin_shufflevector(lo[jj], hi[jj], 0, 1, 2, 3, 4, 5, 6, 7);
        __syncthreads();
    }
}
__device__ __forceinline__ void transpose_convert(const float* __restrict__ W, bf16_t* __restrict__ Wt, int K, int N, const float* __restrict__ kgain, unsigned char* lds_g) { transpose_convert_impl(W, Wt, K, N, kgain, lds_g, (int)blockIdx.x, (int)gridDim.x); }
__device__ __forceinline__ void transpose_convert_part(const float* __restrict__ W, bf16_t* __restrict__ Wt, int K, int N, unsigned char* lds_g, int first, int stride) { transpose_convert_impl(W, Wt, K, N, nullptr, lds_g, first, stride); }
__device__ __forceinline__ void rmsnorm_rows(const float* X, const float* __restrict__ g, bf16_t* H) {
    int tid = threadIdx.x; asm volatile("" : "+v"(tid));
    const int lane = tid & 63, wv = blockIdx.x * 8 + (tid >> 6), nw = gridDim.x * 8;
    f32x4 v[8], vn[8];
    if (wv < MT) { const f32x4* xr = (const f32x4*)(X + (size_t)wv * DM);
#pragma unroll
        for (int i = 0; i < 8; ++i) vn[i] = __builtin_nontemporal_load(xr + lane + 64 * i); }
    for (int row = wv; row < MT; row += nw) {
        float s = 0.f;
#pragma unroll
        for (int i = 0; i < 8; ++i) { v[i] = vn[i]; s += (v[i][0] * v[i][0] + v[i][1] * v[i][1]) + (v[i][2] * v[i][2] + v[i][3] * v[i][3]); }
        if (row + nw < MT) { const f32x4* xr = (const f32x4*)(X + (size_t)(row + nw) * DM);
#pragma unroll
            for (int i = 0; i < 8; ++i) vn[i] = __builtin_nontemporal_load(xr + lane + 64 * i); }
#pragma unroll
        for (int o = 32; o >= 1; o >>= 1) s += __shfl_xor(s, o);
        const float rs = rsqrtf(s * (1.0f / DM) + 1e-6f);
#pragma unroll
        for (int i = 0; i < 8; ++i) { const f32x4 gg = ((const f32x4*)g)[lane + 64 * i]; const f32x4 y = v[i] * rs * gg;
            u32x2 w; w.x = cvt_pk_bf16(y[0], y[1]); w.y = cvt_pk_bf16(y[2], y[3]); *(u32x2*)(H + (size_t)row * DM + 4 * (lane + 64 * i)) = w; }
    }
}
#define MFMA16(a, b, c) __builtin_amdgcn_mfma_f32_16x16x32_bf16((a), (b), (c), 0, 0, 0)
struct AUnit { bf16_t* q; const bf16_t* k; const bf16_t* v; float* lse; int ldq, ldk, d, tq0, first, maxback, newkv, reuse, par; float c2, sink2; };
__device__ __forceinline__ void attn_decode(const Params& p, int step, int vb, AUnit& a) {
    const float LOG2E = 1.4426950408889634f;
    const int G = gridDim.x; const bool packed = (G == 256);
    const int u = packed ? (step < 12 ? 12 * vb + step : 3072 + (step - 12) * 256 + vb) : vb + G * step;
    bf16_t* QA = (bf16_t*)(p.ws + WS_QA); const bf16_t* KA = (const bf16_t*)(p.ws + WS_KA); const bf16_t* VA = (const bf16_t*)(p.ws + WS_VA);
    bf16_t* QB = (bf16_t*)(p.ws + WS_QB); const bf16_t* KB = (const bf16_t*)(p.ws + WS_KB); const bf16_t* VB = (const bf16_t*)(p.ws + WS_VB);
    int hidx;
    a.par = step & 1;
    if (u < 3072) { const int b = u / 1536, rem = u - b * 1536, grp = rem >> 9, h = (rem >> 6) & 7, jr = rem & 63;
        a.d = 1 << (2 * grp); const int nb = 64 >> (2 * grp), r = jr / nb, jb = jr - r * nb;
        a.tq0 = jb * 128 * a.d + r; a.first = (jb == 0);
        const size_t hoff = (size_t)b * TSEQ * 3072 + (size_t)(grp * 8 + h) * 128;
        a.q = QA + hoff; a.k = KA + hoff; a.v = VA + hoff; a.ldq = 3072; a.ldk = 3072; hidx = 16 + grp * 8 + h; a.maxback = 128; a.sink2 = -INFINITY;
        a.lse = (float*)(p.ws + WS_LSE) + ((size_t)grp * MT + (size_t)b * TSEQ) * 8 + h; a.newkv = 1;
        a.reuse = (packed && step > 0 && jb != 0);
    } else { const int u2 = u - 3072, qh = u2 >> 8, sup = u2 & 255, j = sup & 63, kvh = (sup >> 6) & 1, b = sup >> 7;
        a.d = 1; a.tq0 = j * 128; a.first = (j == 0);
        a.q = QB + (size_t)b * TSEQ * 2048 + (size_t)(kvh * 8 + qh) * 128; a.ldq = 2048;
        a.k = KB + (size_t)b * TSEQ * 256 + (size_t)kvh * 128; a.v = VB + (size_t)b * TSEQ * 256 + (size_t)kvh * 128; a.ldk = 256;
        hidx = kvh * 8 + qh; a.maxback = 127; a.sink2 = p.sinks[hidx] * LOG2E; a.lse = nullptr; a.newkv = (qh == 0) || !packed; a.reuse = 0;
        if (packed) a.par = 0; }
    a.c2 = exp2f(-0.2f * (float)(hidx + 1)) * (float)a.d * LOG2E;
}
__device__ __forceinline__ void attn_issue(const AUnit& a, int tid, int wid, int q16, int g, u32x4 (&kr)[4], u32x4 (&vr)[4], bf16x8 (&qf)[4]) {
    const int ch = tid & 15, r0 = tid >> 4;
    if (a.newkv) {
#pragma unroll
        for (int i = 0; i < 4; ++i) { const size_t off = (size_t)(a.tq0 + (r0 + 32 * i) * a.d) * a.ldk + 8 * ch;
            kr[i] = *(const u32x4*)(a.k + off); vr[i] = *(const u32x4*)(a.v + off); } }
    const bf16_t* qrow = a.q + (size_t)(a.tq0 + (16 * wid + q16) * a.d) * a.ldq;
#pragma unroll
    for (int ks = 0; ks < 4; ++ks) qf[ks] = *(const bf16x8*)(qrow + 32 * ks + 8 * g);
}
__device__ __forceinline__ void attn_phase(const Params& p, unsigned char* lds_g) {
    LAS unsigned char* lds = (LAS unsigned char*)lds_g;
    int tid = threadIdx.x; asm volatile("" : "+v"(tid));
    const int lane = tid & 63, wid = __builtin_amdgcn_readfirstlane(tid >> 6), q16 = lane & 15, g = lane >> 4;
    const int G = gridDim.x, vb = (G % 8 == 0) ? ((int)(blockIdx.x & 7) * (G >> 3) + (int)(blockIdx.x >> 3)) : (int)blockIdx.x;
    const int nsteps = (G == 256) ? 20 : (5120 - vb + G - 1) / G;
    const float LN2 = 0.6931471805599453f;
    const float c1 = 0.08838834764831845f * 1.4426950408889634f;
    const int ch = tid & 15, r0 = tid >> 4;
    AUnit cur, nxt; u32x4 kr[4], vr[4]; bf16x8 qfn[4];
    if (nsteps > 0) { attn_decode(p, 0, vb, cur); attn_issue(cur, tid, wid, q16, g, kr, vr, qfn); }
    for (int st = 0; st < nsteps; ++st) {
        if (cur.newkv) {
            const int slotC = cur.par * 128, slotP = (cur.par ^ 1) * 128;
            __syncthreads();
#pragma unroll
            for (int i = 0; i < 4; ++i) { const int row = slotC + r0 + 32 * i;
                *(LAS u32x4*)(lds + K_LDS + row * K_PITCH + ch * 16) = kr[i]; *(LAS u32x4*)(lds + V_LDS + row * V_PITCH + ch * 16) = vr[i]; }
            if (cur.first) {
                const u32x4 z = {0u, 0u, 0u, 0u};
#pragma unroll
                for (int i = 0; i < 4; ++i) *(LAS u32x4*)(lds + V_LDS + (slotP + r0 + 32 * i) * V_PITCH + ch * 16) = z;
            } else if (!cur.reuse) {
                u32x4 kp[4], vp[4];
#pragma unroll
                for (int i = 0; i < 4; ++i) { const size_t off = (size_t)((long)cur.tq0 + (long)(r0 + 32 * i - 128) * cur.d) * cur.ldk + 8 * ch;
                    kp[i] = *(const u32x4*)(cur.k + off); vp[i] = *(const u32x4*)(cur.v + off); }
#pragma unroll
                for (int i = 0; i < 4; ++i) { const int row = slotP + r0 + 32 * i;
                    *(LAS u32x4*)(lds + K_LDS + row * K_PITCH + ch * 16) = kp[i]; *(LAS u32x4*)(lds + V_LDS + row * V_PITCH + ch * 16) = vp[i]; }
            }
            __syncthreads(); }
        bf16x8 qf[4];
#pragma unroll
        for (int ks = 0; ks < 4; ++ks) qf[ks] = qfn[ks];
        if (st + 1 < nsteps) { attn_decode(p, st + 1, vb, nxt); attn_issue(nxt, tid, wid, q16, g, kr, vr, qfn); }
        const int first = cur.first, maxback = cur.maxback; const float c2 = cur.c2, sink2 = cur.sink2;
        const int qtok = cur.tq0 + (16 * wid + q16) * cur.d;
        bf16_t* qrow = cur.q + (size_t)qtok * cur.ldq;
        const int slotC = cur.par * 128, slotP = (cur.par ^ 1) * 128;
        f32x4 s[9];
        bf16x8 ka[2][4];
        { const int T = wid, rowb = ((T < 8) ? slotP : slotC) + (T & 7) * 16;
#pragma unroll
          for (int ks = 0; ks < 4; ++ks) ka[0][ks] = *(const LAS bf16x8*)(lds + K_LDS + (rowb + q16) * K_PITCH + (32 * ks + 8 * g) * 2); }
#pragma unroll
        for (int t = 0; t < 9; ++t) { s[t] = (f32x4){0.f, 0.f, 0.f, 0.f};
            if (t + 1 < 9) { const int T = wid + t + 1, rowb = ((T < 8) ? slotP : slotC) + (T & 7) * 16;
#pragma unroll
                for (int ks = 0; ks < 4; ++ks) ka[(t + 1) & 1][ks] = *(const LAS bf16x8*)(lds + K_LDS + (rowb + q16) * K_PITCH + (32 * ks + 8 * g) * 2); }
            __builtin_amdgcn_sched_barrier(0);
#pragma unroll
            for (int ks = 0; ks < 4; ++ks) s[t] = MFMA16(ka[t & 1][ks], qf[ks], s[t]);
            __builtin_amdgcn_sched_barrier(0); }
        float mx = -INFINITY;
#pragma unroll
        for (int t = 0; t < 9; ++t)
#pragma unroll
            for (int r = 0; r < 4; ++r) { const int rel = 128 + q16 - 16 * t - 4 * g - r, kk = 16 * (wid + t) + 4 * g + r;
                const bool valid = (rel >= 0) && (rel <= maxback) && !(first && kk < 128);
                const float v = valid ? (s[t][r] * c1 - c2 * (float)rel) : -INFINITY; s[t][r] = v; mx = fmaxf(mx, v); }
        mx = fmaxf(mx, __shfl_xor(mx, 16)); mx = fmaxf(mx, __shfl_xor(mx, 32));
        mx = fmaxf(mx, sink2);
        float sum = 0.f;
#pragma unroll
        for (int t = 0; t < 9; ++t)
#pragma unroll
            for (int r = 0; r < 4; ++r) { const float e = __builtin_amdgcn_exp2f(s[t][r] - mx); s[t][r] = e; sum += e; }
        sum += __shfl_xor(sum, 16); sum += __shfl_xor(sum, 32);
        sum += __builtin_amdgcn_exp2f(sink2 - mx);
        bf16x8 pf[5];
#pragma unroll
        for (int uu = 0; uu < 5; ++uu) { u32x4 w; w.x = cvt_pk_bf16(s[2 * uu][0], s[2 * uu][1]); w.y = cvt_pk_bf16(s[2 * uu][2], s[2 * uu][3]);
            if (uu < 4) { w.z = cvt_pk_bf16(s[2 * uu + 1][0], s[2 * uu + 1][1]); w.w = cvt_pk_bf16(s[2 * uu + 1][2], s[2 * uu + 1][3]); } else { w.z = 0u; w.w = 0u; }
            pf[uu] = __builtin_bit_cast(bf16x8, w); }
        const unsigned vcom = (unsigned)(size_t)(lds + V_LDS) + (unsigned)((4 * g + (q16 >> 2)) * V_PITCH + (q16 & 3) * 8);
        unsigned vbase[9];
#pragma unroll
        for (int t = 0; t < 9; ++t) { const int T = wid + t; vbase[t] = vcom + (unsigned)((((T < 8) ? slotP : slotC) + (T & 7) * 16) * V_PITCH); }
        const float inv = 1.0f / sum;
        s16x4 lo[2][5], hi[2][4];
#pragma unroll
        for (int uu = 0; uu < 5; ++uu) { TRRD(lo[0][uu], vbase[2 * uu], 0); if (uu < 4) TRRD(hi[0][uu], vbase[2 * uu + 1], 0); }
#pragma unroll
        for (int dt = 0; dt < 8; ++dt) {
            const int S = dt & 1;
            if (dt + 1 < 8) {
#pragma unroll
                for (int uu = 0; uu < 5; ++uu) { TRRD(lo[S ^ 1][uu], vbase[2 * uu], 32 * (dt + 1)); if (uu < 4) TRRD(hi[S ^ 1][uu], vbase[2 * uu + 1], 32 * (dt + 1)); }
                asm volatile("s_waitcnt lgkmcnt(9)" : "+v"(lo[S][0]), "+v"(lo[S][1]), "+v"(lo[S][2]), "+v"(lo[S][3]), "+v"(lo[S][4]), "+v"(hi[S][0]), "+v"(hi[S][1]), "+v"(hi[S][2]), "+v"(hi[S][3]) :: "memory");
            } else {
                asm volatile("s_waitcnt lgkmcnt(0)" : "+v"(lo[S][0]), "+v"(lo[S][1]), "+v"(lo[S][2]), "+v"(lo[S][3]), "+v"(lo[S][4]), "+v"(hi[S][0]), "+v"(hi[S][1]), "+v"(hi[S][2]), "+v"(hi[S][3]) :: "memory");
            }
            f32x4 o = (f32x4){0.f, 0.f, 0.f, 0.f};
#pragma unroll
            for (int uu = 0; uu < 5; ++uu) { const bf16x8 vf = (uu < 4) ? __builtin_shufflevector(lo[S][uu], hi[S][uu], 0, 1, 2, 3, 4, 5, 6, 7) : __builtin_shufflevector(lo[S][4], lo[S][4], 0, 1, 2, 3, 4, 5, 6, 7);
                o = MFMA16(vf, pf[uu], o); }
            u32x2 w; w.x = cvt_pk_bf16(o[0] * inv, o[1] * inv); w.y = cvt_pk_bf16(o[2] * inv, o[3] * inv);
            *(u32x2*)(qrow + 16 * dt + 4 * g) = w;
        }
        if (cur.lse && g == 0) cur.lse[(size_t)qtok * 8] = (mx + __builtin_amdgcn_logf(sum)) * LN2;
        cur = nxt;
    }
    __syncthreads();
}
__device__ __forceinline__ void combine_phase(const Params& p) {
    const bf16_t* QA = (const bf16_t*)(p.ws + WS_QA); const float* LSE = (const float*)(p.ws + WS_LSE); bf16_t* OA = (bf16_t*)((unsigned char*)p.out + DO_OA);
    const int nthr = gridDim.x * 512;
    int tid = threadIdx.x; asm volatile("" : "+v"(tid));
#pragma unroll 4
    for (int idx = blockIdx.x * 512 + tid; idx < MT * 128; idx += nthr) {
        const int tok = idx >> 7, hc = idx & 127, h = hc >> 4, c = hc & 15;
        const float l0 = LSE[((size_t)0 * MT + tok) * 8 + h], l1 = LSE[((size_t)1 * MT + tok) * 8 + h], l2 = LSE[((size_t)2 * MT + tok) * 8 + h];
        const float mx = fmaxf(l0, fmaxf(l1, l2)); float w0 = __expf(l0 - mx), w1 = __expf(l1 - mx), w2 = __expf(l2 - mx); const float inv = 1.0f / (w0 + w1 + w2); w0 *= inv; w1 *= inv; w2 *= inv;
        const bf16_t* base = QA + (size_t)tok * 3072 + h * 128 + 8 * c;
        const u32x4 a = __builtin_nontemporal_load((const u32x4*)(base)), b = __builtin_nontemporal_load((const u32x4*)(base + 1024)), cc = __builtin_nontemporal_load((const u32x4*)(base + 2048));
        u32x4 o;
#pragma unroll
        for (int j = 0; j < 4; ++j) { const float lo = w0 * bf_lo(a[j]) + w1 * bf_lo(b[j]) + w2 * bf_lo(cc[j]), hi = w0 * bf_hi(a[j]) + w1 * bf_hi(b[j]) + w2 * bf_hi(cc[j]); o[j] = cvt_pk_bf16(lo, hi); }
        *(u32x4*)(OA + (size_t)tok * 1024 + h * 128 + 8 * c) = o;
    }
}

__device__ __forceinline__ void grid_bar(unsigned* ctr, unsigned target) {
    asm volatile("s_waitcnt vmcnt(0)" ::: "memory");
    __syncthreads();
    if (threadIdx.x == 0) {
        __builtin_amdgcn_fence(__ATOMIC_RELEASE, "agent");
        asm volatile("s_waitcnt vmcnt(0)" ::: "memory");
        __hip_atomic_fetch_add(ctr, 1u, __ATOMIC_RELAXED, __HIP_MEMORY_SCOPE_AGENT);
        while (__hip_atomic_load(ctr, __ATOMIC_RELAXED, __HIP_MEMORY_SCOPE_AGENT) < target) __builtin_amdgcn_s_sleep(2);
        __builtin_amdgcn_fence(__ATOMIC_ACQUIRE, "agent");
        asm volatile("s_waitcnt vmcnt(0)" ::: "memory");
    }
    __syncthreads();
}
__global__ void __launch_bounds__(512, 2) mega(Params p) {
    extern __shared__ __attribute__((aligned(16))) unsigned char lds[];
    cg::grid_group grid = cg::this_grid();
    PG8_LAS unsigned char* L = (PG8_LAS unsigned char*)lds;
    const int G = gridDim.x, c = blockIdx.x;
    unsigned* bar = (unsigned*)(p.ws + WS_BAR); unsigned* gbar = bar + 64 * (1 + (c & 7)); const bool grouped = (G % 8 == 0);
    unsigned char* ws = p.ws; unsigned char* ob = (unsigned char*)p.out;
    bf16_t* H = (bf16_t*)(ob + DO_H); bf16_t* WtIn = (bf16_t*)(ob + DO_WIN); bf16_t* OA = (bf16_t*)(ob + DO_OA);
    bf16_t* WtBa = (bf16_t*)(ws + WS_WBA); bf16_t* WtBb = (bf16_t*)(ws + WS_WBB); bf16_t* WtOut = (bf16_t*)(ws + WS_WOUT); bf16_t* WtF1 = (bf16_t*)(ws + WS_WFF1); bf16_t* WtF2 = (bf16_t*)(ws + WS_WFF2);
    bf16_t* MRG = (bf16_t*)(ws + WS_MRG); bf16_t* H2 = (bf16_t*)(ws + WS_H2); bf16_t* ACT = (bf16_t*)(ws + WS_ACT);
    transpose_convert(p.w_in, WtIn, DM, INC, nullptr, lds);
    rmsnorm_rows(p.x, p.norm1_g, H);
    grid.sync();
    { PG8_LAS float* gl = (PG8_LAS float*)(L + pg8::STAGE_BYTES + 8192); const int t = threadIdx.x;
      gl[t] = (t < 128) ? p.qna[t] : (t < 256) ? p.kna[t - 128] : (t < 384) ? p.qnb[t - 256] : p.knb[t - 384]; __syncthreads(); }
    { pg8::Gemm g{H, WtIn, MT, INC, DM}; pg8::StaticOrder S; S.init(MT, INC, G, c, 1);
      pg8::EpiProj E{(bf16_t*)(ws + WS_QA), (bf16_t*)(ws + WS_KA), (bf16_t*)(ws + WS_VA), (bf16_t*)(ws + WS_QB), (bf16_t*)(ws + WS_KB), (bf16_t*)(ws + WS_VB), (bf16_t*)(ws + WS_GA), (bf16_t*)(ws + WS_GB)};
      pg8::gemm_phase(L, g, S, E); }
    if (G == 256) { if (c >= 128) { transpose_convert_part(p.wba, WtBa, 1024, DM, lds, c - 128, 128); transpose_convert_part(p.wbb, WtBb, DM, DM, lds, c - 128, 128); } }
    else { transpose_convert(p.wba, WtBa, 1024, DM, nullptr, lds); transpose_convert(p.wbb, WtBb, DM, DM, nullptr, lds); }
    grid_bar(bar, 1u * (unsigned)G);
    attn_phase(p, lds);
    grid_bar(bar, 2u * (unsigned)G);
    transpose_convert(p.wff2, WtF2, DFF, DM, nullptr, lds);
    transpose_convert(p.wff1, WtF1, DM, DFF, p.norm2_g, lds);
    transpose_convert(p.wout, WtOut, DM, DM, nullptr, lds);
    combine_phase(p);
    grid_bar(bar, 3u * (unsigned)G);
    { pg8::Gemm g{OA, WtBa, MT, DM, 1024}; pg8::StaticOrder S; S.init(MT, DM, G, c);
      pg8::EpiGate E{(const bf16_t*)(ws + WS_GA), nullptr, MRG, DM}; pg8::gemm_phase(L, g, S, E); }
    { pg8::Gemm g{(const bf16_t*)(ws + WS_QB), WtBb, MT, DM, DM}; pg8::StaticOrder S; S.init(MT, DM, G, c);
      pg8::EpiGate E{(const bf16_t*)(ws + WS_GB), MRG, MRG, DM}; pg8::gemm_phase(L, g, S, E); }
    if (grouped) grid_bar(gbar, 1u * (unsigned)(G >> 3)); else grid_bar(bar, 4u * (unsigned)G);
    { pg8::Gemm g{MRG, WtOut, MT, DM, DM}; pg8::StaticOrder S; S.init(MT, DM, G, c);
      pg8::EpiResX1 E{p.x, H2, (float*)(ws + WS_SSQ), DM}; pg8::gemm_phase(L, g, S, E); }
    grid_bar(bar, (grouped ? 4u : 5u) * (unsigned)G);
    { pg8::Gemm g{H2, WtF1, MT, DFF, DM}; pg8::StaticOrder S; S.init(MT, DFF, G, c, 1);
      pg8::Unit u0; if (S.next(0, u0)) { PG8_LAS float* RS = (PG8_LAS float*)(L + pg8::STAGE_BYTES + 8192 + 2048); const int t = threadIdx.x;
          if (t < 256) { const float* sp = (const float*)(ws + WS_SSQ) + (size_t)(u0.pm * 256 + t) * 8; const f32x4 p0 = *(const f32x4*)sp, p1 = *(const f32x4*)(sp + 4);
              RS[t] = rsqrtf((((p0[0] + p0[1]) + (p0[2] + p0[3])) + ((p1[0] + p1[1]) + (p1[2] + p1[3]))) * (1.0f / 2048.0f) + 1e-6f); } }
      __syncthreads();
      pg8::EpiRelu2 E{ACT, ACT_LD}; pg8::gemm_phase(L, g, S, E); }
    if (grouped) grid_bar(gbar, 2u * (unsigned)(G >> 3)); else grid_bar(bar, 6u * (unsigned)G);
    { pg8::Gemm g{ACT, WtF2, MT, DM, DFF, ACT_LD}; pg8::StaticOrder S; S.init(MT, DM, G, c);
      pg8::EpiFinal E{H2, p.out, DM}; pg8::gemm_phase(L, g, S, E); }
}

extern "C" void kernel_launch(void* const* d_in, const int* in_sizes, int n_in, void* d_out, int out_size, void* d_ws, size_t ws_size, hipStream_t stream) {
    static int grid_blocks = 0;
    if (!grid_blocks) {
        if (n_in != 14 || out_size != MT * DM || ws_size < WS_NEED) { fprintf(stderr, "kernel_launch: unexpected shapes (n_in %d out %d ws %zu)\n", n_in, out_size, ws_size); grid_blocks = -1; return; }
        int dev = 0, cus = 0, per_cu = 0;
        (void)hipGetDevice(&dev); (void)hipDeviceGetAttribute(&cus, hipDeviceAttributeMultiprocessorCount, dev);
        if (hipFuncSetAttribute((const void*)mega, hipFuncAttributeMaxDynamicSharedMemorySize, LDS_BYTES) != hipSuccess) { fprintf(stderr, "kernel_launch: hipFuncSetAttribute failed\n"); grid_blocks = -1; return; }
        (void)hipOccupancyMaxActiveBlocksPerMultiprocessor(&per_cu, (const void*)mega, 512, LDS_BYTES);
        if (per_cu < 1) { fprintf(stderr, "kernel_launch: occupancy query says %d blocks/CU\n", per_cu); }
        (void)hipGetLastError();
        if (cus % 64 != 0) { fprintf(stderr, "kernel_launch: built for a CU count that is a multiple of 64 (MI355X: 256), got %d; nothing launched\n", cus); grid_blocks = -1; return; }
        grid_blocks = cus;
    }
    if (grid_blocks < 0) return;
    Params p{};
    p.x = (const float*)d_in[0]; p.norm1_g = (const float*)d_in[1]; p.w_in = (const float*)d_in[2]; p.qna = (const float*)d_in[3]; p.kna = (const float*)d_in[4];
    p.qnb = (const float*)d_in[5]; p.knb = (const float*)d_in[6]; p.sinks = (const float*)d_in[7]; p.wba = (const float*)d_in[8]; p.wbb = (const float*)d_in[9];
    p.wout = (const float*)d_in[10]; p.norm2_g = (const float*)d_in[11]; p.wff1 = (const float*)d_in[12]; p.wff2 = (const float*)d_in[13];
    p.out = (float*)d_out; p.ws = (unsigned char*)d_ws;
    if (hipMemsetAsync((unsigned char*)d_ws + WS_BAR, 0, 4096, stream) != hipSuccess) { fprintf(stderr, "kernel_launch: memset of the barrier word failed\n"); return; }
    void* args[] = {&p};
    hipError_t e = hipLaunchCooperativeKernel((const void*)mega, dim3(grid_blocks), dim3(512), args, LDS_BYTES, stream);
    if (e != hipSuccess) fprintf(stderr, "cooperative launch failed: %s (grid %d)\n", hipGetErrorString(e), grid_blocks);
}
```
